# Optimizing an MI355X kernel written in HIP

```python
import math, functools
import jax, jax.numpy as jnp
from jax import lax
import numpy as np

D_MODEL = 1024
BATCH = 8
SEQ = 2048
DEPTH = 1
DEC_BATCH = 128
DEC_SEQ = 8
PAST_LEN = 16384
PAGE_SIZE = 128

D_INNER = 2 * D_MODEL
D_POOL = D_INNER // 2
D_MLSTM = D_INNER - D_POOL
POOL_WINDOWS = (2, 4, 8, 16)
N_POOL_GROUPS = len(POOL_WINDOWS)
POOL_GROUP = D_POOL // N_POOL_GROUPS
POOL_BUF = max(POOL_WINDOWS) - 1
N_HEADS = 4
HEAD_DIM = D_MLSTM // N_HEADS
CHUNK = 64
N_META = 16
EPS = 1e-6
D_PROJ = 2 * D_POOL + 5 * D_MLSTM + 2 * N_HEADS

kernel_name = "hymba_pool_mlstm_decoder_step"


def rms_norm(x, w):
    xf = x.astype(jnp.float32)
    y = xf * lax.rsqrt(jnp.mean(xf * xf, axis=-1, keepdims=True) + EPS) * w.astype(jnp.float32)
    return y.astype(x.dtype)


def causal_multiscale_pool(u, prev, pos0):
    B, T, C = u.shape
    P = POOL_BUF
    ext = jnp.concatenate([prev.astype(jnp.float32), u.astype(jnp.float32)], axis=1)
    cs0 = jnp.concatenate([jnp.zeros((B, 1, C), jnp.float32), jnp.cumsum(ext, axis=1)], axis=1)
    end = cs0[:, P + 1:]
    pos = pos0 + jnp.arange(T)
    cur = ext[:, P:]
    outs = []
    for g, w in enumerate(POOL_WINDOWS):
        sl = slice(g * POOL_GROUP, (g + 1) * POOL_GROUP)
        start = cs0[:, P + 1 - w: P + 1 - w + T, sl]
        cnt = jnp.minimum(w, pos + 1).astype(jnp.float32)
        outs.append((end[..., sl] - start) / cnt[None, :, None] - cur[..., sl])
    return jnp.concatenate(outs, axis=-1), ext[:, -P:]


def mlstm_chunk(state, inp):
    C, n, m = state
    q, k, v, ig, lf = inp
    L = q.shape[2]
    b = jnp.cumsum(lf, axis=-1)
    causal = jnp.tril(jnp.ones((L, L), dtype=bool))
    D = jnp.where(causal, b[..., :, None] - b[..., None, :] + ig[..., None, :], -jnp.inf)
    a = b + m[..., None]
    m_t = jnp.maximum(a, jnp.max(D, axis=-1))
    W = jnp.exp(D - m_t[..., None])
    inter = jnp.exp(a - m_t)
    s = jnp.einsum('bhtd,bhsd->bhts', q, k) * W
    num = inter[..., None] * jnp.einsum('bhtd,bhde->bhte', q, C) + jnp.einsum('bhts,bhse->bhte', s, v)
    qn = inter * jnp.einsum('bhtd,bhd->bht', q, n) + jnp.sum(s, axis=-1)
    h = num / jnp.maximum(jnp.abs(qn), jnp.exp(-m_t))[..., None]
    m_new = m_t[..., -1]
    w_end = jnp.exp(b[..., -1:] - b + ig - m_new[..., None])
    decay = jnp.exp(b[..., -1] + m - m_new)
    C_new = decay[..., None, None] * C + jnp.einsum('bhs,bhsd,bhse->bhde', w_end, k, v)
    n_new = decay[..., None] * n + jnp.einsum('bhs,bhsd->bhd', w_end, k)
    return (C_new, n_new, m_new), h


def mlstm_prompt(q, k, v, ig, lf):
    B, H, T, _ = q.shape
    state = (jnp.zeros((B, H, HEAD_DIM, HEAD_DIM), jnp.float32),
             jnp.zeros((B, H, HEAD_DIM), jnp.float32),
             jnp.zeros((B, H), jnp.float32))
    state, h_meta = mlstm_chunk(state, tuple(a[:, :, :N_META] for a in (q, k, v, ig, lf)))
    nc = (T - N_META) // CHUNK

    def to_chunks(a):
        a = a[:, :, N_META:]
        return jnp.moveaxis(a.reshape(B, H, nc, CHUNK, *a.shape[3:]), 2, 0)

    state, h_c = lax.scan(mlstm_chunk, state, tuple(to_chunks(a) for a in (q, k, v, ig, lf)))
    h_c = jnp.moveaxis(h_c, 0, 2).reshape(B, H, T - N_META, HEAD_DIM)
    return state, jnp.concatenate([h_meta, h_c], axis=2)


def mlstm_sample(state, q, k, v, ig, lf):
    state = tuple(s.astype(jnp.float32) for s in state)
    return mlstm_chunk(state, (q, k, v, ig, lf))


def mixer_layer(h, pool_prev, pos0, mlstm_run, norm_w, w_in, b_if, w_pool, pool_scale, mhln_w, w_out):
    B, T, _ = h.shape
    f32 = jnp.float32
    xn = rms_norm(h, norm_w)
    proj = xn @ w_in
    cuts = np.cumsum([D_POOL, D_POOL, D_MLSTM, D_MLSTM, D_MLSTM, D_MLSTM, D_MLSTM, N_HEADS])
    u_a, z_a, q, k, v, o, z_b, i_pre, f_pre = jnp.split(proj, cuts, axis=-1)
    pooled, pool_rows = causal_multiscale_pool(u_a, pool_prev, pos0)
    mixed = jnp.einsum('btgc,gcd->btgd', pooled.reshape(B, T, N_POOL_GROUPS, POOL_GROUP),
                       w_pool.astype(f32)).reshape(B, T, D_POOL)
    y_a = mixed * pool_scale.astype(f32) * jax.nn.silu(z_a.astype(f32))
    def heads(a):
        return a.astype(f32).reshape(B, T, N_HEADS, HEAD_DIM).transpose(0, 2, 1, 3)
    qh, kh, vh = heads(q), heads(k) * (HEAD_DIM ** -0.5), heads(v)
    gb = b_if.astype(f32)
    ig = (i_pre.astype(f32) + gb[:N_HEADS]).transpose(0, 2, 1)
    lf = jax.nn.log_sigmoid(f_pre.astype(f32) + gb[N_HEADS:]).transpose(0, 2, 1)
    state, ht = mlstm_run(qh, kh, vh, ig, lf)
    mu = jnp.mean(ht, axis=-1, keepdims=True)
    var = jnp.mean(jnp.square(ht - mu), axis=-1, keepdims=True)
    hn = (ht - mu) * lax.rsqrt(var + EPS) * mhln_w.astype(f32)[None, :, None, :]
    hn = hn.transpose(0, 2, 1, 3).reshape(B, T, D_MLSTM)
    y_b = hn * jax.nn.sigmoid(o.astype(f32)) * jax.nn.silu(z_b.astype(f32))
    y = jnp.concatenate([y_a, y_b], axis=-1).astype(h.dtype) @ w_out
    return h + y, pool_rows, state


def setup_inputs(seed: int = 0) -> dict:
    key = jax.random.key(seed)
    ks = jax.random.split(key, 18)
    nrm = jax.random.normal
    G = POOL_GROUP
    b_i = 0.1 * nrm(ks[10], (DEPTH, N_HEADS))
    b_f = jnp.linspace(3.0, 6.0, N_HEADS)[None, :] + 0.1 * nrm(ks[11], (DEPTH, N_HEADS))
    return {
        "x_prompt": nrm(ks[0], (BATCH, SEQ, D_MODEL), jnp.float32),
        "x_sample": nrm(ks[1], (DEC_BATCH, DEC_SEQ, D_MODEL), jnp.float32),
        "state_pool": nrm(ks[2], (DEPTH, DEC_BATCH, POOL_BUF, D_POOL), jnp.float32),
        "state_C": 0.1 * nrm(ks[3], (DEPTH, DEC_BATCH, N_HEADS, HEAD_DIM, HEAD_DIM), jnp.float32),
        "state_n": 0.1 * nrm(ks[4], (DEPTH, DEC_BATCH, N_HEADS, HEAD_DIM), jnp.float32),
        "state_m": nrm(ks[5], (DEPTH, DEC_BATCH, N_HEADS), jnp.float32),
        "meta_tokens": nrm(ks[6], (N_META, D_MODEL), jnp.float32),
        "norm1_w": 1.0 + 0.1 * nrm(ks[7], (DEPTH, D_MODEL), jnp.float32),
        "w_in": nrm(ks[8], (DEPTH, D_MODEL, D_PROJ), jnp.float32) * D_MODEL ** -0.5,
        "b_if": jnp.concatenate([b_i, b_f], axis=-1).astype(jnp.float32),
        "w_pool": nrm(ks[12], (DEPTH, N_POOL_GROUPS, G, G), jnp.float32) * G ** -0.5,
        "pool_scale": 1.0 + 0.1 * nrm(ks[13], (DEPTH, D_POOL), jnp.float32),
        "mhln_w": 1.0 + 0.1 * nrm(ks[14], (DEPTH, N_HEADS, HEAD_DIM), jnp.float32),
        "w_out": nrm(ks[15], (DEPTH, D_INNER, D_MODEL), jnp.float32) * D_INNER ** -0.5,
        "normf_w": 1.0 + 0.1 * nrm(ks[16], (D_MODEL,), jnp.float32),
    }


def reference(x_prompt, x_sample, state_pool, state_C, state_n, state_m, meta_tokens, norm1_w, w_in,
              b_if, w_pool, pool_scale, mhln_w, w_out, normf_w):
    Bp = x_prompt.shape[0]
    meta = jnp.broadcast_to(meta_tokens.astype(x_prompt.dtype)[None], (Bp, N_META, D_MODEL))
    hp = jnp.concatenate([meta, x_prompt], axis=1)
    hs = x_sample
    pool_p, C_p, n_p, m_p = [], [], [], []
    pool_s, C_s, n_s, m_s = [], [], [], []
    for l in range(DEPTH):
        w = (norm1_w[l], w_in[l], b_if[l], w_pool[l], pool_scale[l], mhln_w[l], w_out[l])
        hp, pr, (cp, np_, mp) = mixer_layer(hp, jnp.zeros((Bp, POOL_BUF, D_POOL), hp.dtype), 0,
                                            mlstm_prompt, *w)
        run_s = functools.partial(mlstm_sample, (state_C[l], state_n[l], state_m[l]))
        hs, ps, (cs, ns, ms) = mixer_layer(hs, state_pool[l], PAST_LEN, run_s, *w)
        pool_p.append(pr); C_p.append(cp); n_p.append(np_); m_p.append(mp)
        pool_s.append(ps); C_s.append(cs); n_s.append(ns); m_s.append(ms)
    y_prompt = rms_norm(hp, normf_w)[:, N_META:]
    y_sample = rms_norm(hs, normf_w)
    return (y_prompt, y_sample,
            jnp.stack(pool_p), jnp.stack(C_p), jnp.stack(n_p), jnp.stack(m_p),
            jnp.stack(pool_s), jnp.stack(C_s), jnp.stack(n_s), jnp.stack(m_s))
```

```cpp
#include <hip/hip_runtime.h>
#include <hip/hip_cooperative_groups.h>
#include <cstdio>
#ifndef MK_MULTI
#define MK_MULTI 1
#endif
namespace pg8 {
#define PG8_LAS __attribute__((address_space(3)))
typedef unsigned short bf16_t;
typedef short bf16x8 __attribute__((ext_vector_type(8)));
typedef float f32x4 __attribute__((ext_vector_type(4)));
typedef unsigned u32x4 __attribute__((ext_vector_type(4)));
constexpr int BM = 256, BK = 64, HALF = 128, HTB = HALF * BK * 2  , STAGE_BYTES = 8 * HTB, NXCD = 8, WGM = 8;

__host__ __device__ __forceinline__ int lds_byte(int r, int c) { const int st = (r >> 4) * 2 + (c >> 5), rr = r & 15, cc = c & 31, ob = rr * 64 + cc * 2; return st * 1024 + (ob ^ (((ob >> 9) & 1) << 5)); }
__host__ __device__ __forceinline__ void stage_rc(int b, int& R, int& C) { const int st = b / 1024, sb = b % 1024, swz = sb ^ (((sb >> 9) & 1) << 5); R = (st >> 1) * 16 + swz / 64; C = (st & 1) * 32 + (swz % 64) / 2; }
__host__ __device__ __forceinline__ int perm32(int rho) { const int n = rho >> 4, i = rho & 15; return 8 * (i >> 2) + 4 * n + (i & 3); }

struct Unit { int pm, pn; };
struct Gemm { const bf16_t* A; const bf16_t* Bt; int M, N, K; };

struct StaticOrder {
    int nM, nN, nwg, G, c;
    __host__ __device__ void init(int M, int N, int G_, int c_) { nM = M / BM; nN = N / BM; nwg = nM * nN; G = G_; c = c_; }
    __host__ __device__ bool next(int i, Unit& u) const {
        const long L = (long)i * G + c; if (L >= nwg) return false;
        int wgid = (int)L; { const int q = nwg / NXCD, r = nwg % NXCD, xcd = wgid % NXCD, off = wgid / NXCD; wgid = (xcd < r ? xcd * (q + 1) : r * (q + 1) + (xcd - r) * q) + off; }
        const int nig = WGM * nN, gid = wgid / nig, fm = gid * WGM, gsz = (nM - fm) < WGM ? (nM - fm) : WGM;
        u.pm = fm + ((wgid % nig) % gsz); u.pn = (wgid % nig) / gsz; return true;
    }
    __device__ __forceinline__ void a_ready(const Unit&) const {}
    __device__ __forceinline__ void done(const Unit&) const {}
};

template <class Epi, class Sched, bool STAMP = false>
__device__ __forceinline__ void gemm_phase(PG8_LAS unsigned char* lds, const Gemm g, const Sched& S, const Epi& E, unsigned long long* stamps) {
    const int tid = threadIdx.x, wid = __builtin_amdgcn_readfirstlane(tid >> 6), lane = tid & 63, wr = wid >> 2, wc = wid & 3, fr = lane & 15, fq = lane >> 4;
    const int K = g.K, nt = K / BK;
    int ts_lo = 0, ts_hi = 0, nts = 0; const unsigned long long rt_entry = STAMP ? (unsigned long long)wall_clock64() : 0ull;
#define PG8_STAMP() do { if (STAMP && wid == 0 && nts < 64) { const unsigned long long _c = (unsigned long long)clock64(); \
        ts_lo = (lane == nts) ? (int)(unsigned)_c : ts_lo; ts_hi = (lane == nts) ? (int)(unsigned)(_c >> 32) : ts_hi; ++nts; } } while (0)
    PG8_STAMP();
    unsigned voffA[2], voffB[2];
#pragma unroll
    for (int i = 0; i < 2; ++i) { int R, C; stage_rc(tid * 16 + i * 8192, R, C); const int Rb = Epi::PERM ? ((R & ~31) + perm32(R & 31)) : R;
        voffA[i] = (unsigned)(R * K + C) * 2u; voffB[i] = (unsigned)(Rb * K + C) * 2u; }
    const size_t kstep = (size_t)(BK * 2);
    const size_t hstep = (size_t)HALF * K * 2;
    const size_t tstep = 2 * hstep;
    const unsigned ldsw = (unsigned)wid * 1024u;
    const int aoff = lds_byte(wr * 64 + fr, fq * 8), boff = lds_byte(wc * 32 + fr, fq * 8);
#define PG8_SA(b, h) (((b) * 2 + (h)) * HTB)
#define PG8_SB(b, h) ((4 + (b) * 2 + (h)) * HTB)
#define PG8_STAGE(bufoff, gbase, voff) do { _Pragma("unroll") for (int _i = 0; _i < 2; ++_i) \
        __builtin_amdgcn_global_load_lds((const unsigned*)((const char*)(gbase) + (voff)[_i]), (PG8_LAS unsigned*)(lds + (bufoff) + ldsw + _i * 8192), 16, 0, 0); } while (0)
#define PG8_LDA(dst, b, h) do { _Pragma("unroll") for (int m = 0; m < 4; ++m) _Pragma("unroll") for (int k = 0; k < 2; ++k) dst[m][k] = *(const PG8_LAS bf16x8*)(lds + PG8_SA(b, h) + aoff + m * 2048 + k * 1024); } while (0)
#define PG8_LDB(dst, b, h) do { _Pragma("unroll") for (int n = 0; n < 2; ++n) _Pragma("unroll") for (int k = 0; k < 2; ++k) dst[n][k] = *(const PG8_LAS bf16x8*)(lds + PG8_SB(b, h) + boff + n * 2048 + k * 1024); } while (0)
#define PG8_MMA(ai, bj, At, Bt) do { __builtin_amdgcn_s_setprio(1); _Pragma("unroll") for (int m = 0; m < 4; ++m) _Pragma("unroll") for (int n = 0; n < 2; ++n) _Pragma("unroll") for (int k = 0; k < 2; ++k) \
        acc[ai][bj][m][n] = __builtin_amdgcn_mfma_f32_16x16x32_bf16(Bt[n][k], At[m][k], acc[ai][bj][m][n], 0, 0, 0); __builtin_amdgcn_s_setprio(0); } while (0)
#define PG8_WAIT_V(n) asm volatile("s_waitcnt vmcnt(" #n ")" ::: "memory")
#define PG8_WAIT_L(n) asm volatile("s_waitcnt lgkmcnt(" #n ")" ::: "memory")
#define PG8_BAR __builtin_amdgcn_s_barrier()
#define PG8_SCHED __builtin_amdgcn_sched_barrier(0)
    Unit cur, nxt; int ui = 0;
    if (!S.next(0, cur)) return;
    f32x4 acc[2][2][4][2];
#pragma unroll
    for (int a = 0; a < 2; ++a)
#pragma unroll
        for (int b = 0; b < 2; ++b)
#pragma unroll
            for (int m = 0; m < 4; ++m)
#pragma unroll
                for (int n = 0; n < 2; ++n) acc[a][b][m][n] = (f32x4){0.f, 0.f, 0.f, 0.f};
    bf16x8 At[4][2], B0[2][2], B1[2][2];
    const char* cA = (const char*)g.A + (size_t)cur.pm * tstep; const char* cB = (const char*)g.Bt + (size_t)cur.pn * tstep;
    S.a_ready(cur);
    PG8_STAGE(PG8_SB(0, 0), cB, voffB); PG8_STAGE(PG8_SA(0, 0), cA, voffA); PG8_STAGE(PG8_SB(0, 1), cB + hstep, voffB); PG8_STAGE(PG8_SA(0, 1), cA + hstep, voffA);
    if (wr == 1) PG8_BAR;
    PG8_WAIT_V(4); PG8_BAR;
    PG8_STAGE(PG8_SB(1, 0), cB + kstep, voffB); PG8_STAGE(PG8_SA(1, 0), cA + kstep, voffA); PG8_STAGE(PG8_SB(1, 1), cB + hstep + kstep, voffB);
    PG8_WAIT_V(6); PG8_BAR;
    PG8_STAMP();
    for (;;) {
        const bool has_next = S.next(ui + 1, nxt);
        const char* nA = has_next ? (const char*)g.A + (size_t)nxt.pm * tstep : cA; const char* nB = has_next ? (const char*)g.Bt + (size_t)nxt.pn * tstep : cB;
        for (int t = 0; t < nt; t += 2) {
            const bool last = (t == nt - 2);
            const char* a1 = cA + (size_t)(t + 1) * kstep;
            const char* a2 = last ? nA : cA + (size_t)(t + 2) * kstep; const char* b2 = last ? nB : cB + (size_t)(t + 2) * kstep;
            const char* a3 = a2 + kstep; const char* b3 = b2 + kstep;
            if (last && has_next) S.a_ready(nxt);
            PG8_LDB(B0, 0, 0); PG8_SCHED; PG8_LDA(At, 0, 0); PG8_STAGE(PG8_SA(1, 1), a1 + hstep, voffA);
            PG8_WAIT_L(8); PG8_BAR; PG8_WAIT_L(0); PG8_MMA(0, 0, At, B0); PG8_BAR; PG8_SCHED;
            PG8_LDB(B1, 0, 1); PG8_STAGE(PG8_SB(0, 0), b2, voffB);
            PG8_BAR; PG8_WAIT_L(0); PG8_MMA(0, 1, At, B1); PG8_BAR;
            PG8_LDA(At, 0, 1); PG8_STAGE(PG8_SA(0, 0), a2, voffA);
            PG8_BAR; PG8_WAIT_L(0); PG8_MMA(1, 0, At, B0); PG8_BAR; PG8_SCHED;
            PG8_STAGE(PG8_SB(0, 1), b2 + hstep, voffB);
            PG8_WAIT_V(6); PG8_BAR; PG8_MMA(1, 1, At, B1); PG8_BAR;
            PG8_LDB(B0, 1, 0); PG8_SCHED; PG8_LDA(At, 1, 0); PG8_STAGE(PG8_SA(0, 1), a2 + hstep, voffA);
            PG8_WAIT_L(8); PG8_BAR; PG8_WAIT_L(0); PG8_MMA(0, 0, At, B0); PG8_BAR; PG8_SCHED;
            PG8_LDB(B1, 1, 1); PG8_STAGE(PG8_SB(1, 0), b3, voffB);
            PG8_BAR; PG8_WAIT_L(0); PG8_MMA(0, 1, At, B1); PG8_BAR;
            PG8_LDA(At, 1, 1); PG8_STAGE(PG8_SA(1, 0), a3, voffA);
            PG8_BAR; PG8_WAIT_L(0); PG8_MMA(1, 0, At, B0); PG8_BAR; PG8_SCHED;
            PG8_STAGE(PG8_SB(1, 1), b3 + hstep, voffB);
            PG8_WAIT_V(6); PG8_BAR; PG8_MMA(1, 1, At, B1); PG8_BAR;
        }
        PG8_STAMP();
        if constexpr (!Epi::AFTER_DRAIN) { E(acc, cur, wr, wc, fr, fq); S.done(cur); }
        PG8_STAMP();
        if (!has_next) break;
#pragma unroll
        for (int a = 0; a < 2; ++a)
#pragma unroll
            for (int b = 0; b < 2; ++b)
#pragma unroll
                for (int m = 0; m < 4; ++m)
#pragma unroll
                    for (int n = 0; n < 2; ++n) acc[a][b][m][n] = (f32x4){0.f, 0.f, 0.f, 0.f};
        cur = nxt; cA = nA; cB = nB; ++ui;
    }
    PG8_WAIT_V(0);
    if (wr == 0) PG8_BAR;
    PG8_BAR;
    if constexpr (Epi::AFTER_DRAIN) { E.fused(acc, cur, wr, wc, fr, fq, lds, wid, lane); S.done(cur); }
    PG8_STAMP();
    if (STAMP && wid == 0) { stamps[lane] = lane < nts ? (((unsigned long long)(unsigned)ts_hi << 32) | (unsigned)ts_lo) : 0ull;
        if (lane == 62) stamps[62] = rt_entry; if (lane == 63) stamps[63] = (unsigned long long)wall_clock64(); }
#undef PG8_STAMP
#undef PG8_SA
#undef PG8_SB
#undef PG8_STAGE
#undef PG8_LDA
#undef PG8_LDB
#undef PG8_MMA
#undef PG8_WAIT_V
#undef PG8_WAIT_L
#undef PG8_BAR
#undef PG8_SCHED
}
}
namespace cg = cooperative_groups;
using pg8::bf16_t; using pg8::bf16x8; using pg8::f32x4; using pg8::u32x4; using pg8::Unit;
#define LAS __attribute__((address_space(3)))
typedef short s16x4 __attribute__((ext_vector_type(4)));
typedef unsigned u32x2 __attribute__((ext_vector_type(2)));
typedef __bf16 bf2_t __attribute__((ext_vector_type(2)));
typedef float f2_t __attribute__((ext_vector_type(2)));
#define DI __device__ __forceinline__

constexpr int DM = 1024, SEQ = 2048, NMETA = 16, TPR = 2064, ROWS_P = 16512, ROWS_S = 1024, T = 17536, TP = 17664;
constexpr int DPROJ = 7176;
constexpr size_t O_YP = 0, O_YS = 16777216, O_PP = O_YS + 1048576, O_CP = O_PP + 122880, O_NP = O_CP + 2097152, O_MP = O_NP + 8192,
                 O_PS = O_MP + 32, O_CS = O_PS + 1966080, O_NS = O_CS + 33554432, O_MS = O_NS + 131072;
constexpr size_t SZ_ACT = (size_t)TP * 1024 * 2;
constexpr size_t W_XN = 0, W_WIN = W_XN + SZ_ACT, W_WOUT = W_WIN + (size_t)7168 * 1024 * 2, W_WPOOL = W_WOUT + (size_t)1024 * 2048 * 2,
                 W_GATES = W_WPOOL + 524288, W_U = W_GATES + (size_t)TP * 32, W_ZA = W_U + SZ_ACT, W_Q = W_ZA + SZ_ACT, W_K = W_Q + SZ_ACT,
                 W_V = W_K + SZ_ACT, W_G = W_V + SZ_ACT, W_HT = W_G + SZ_ACT, W_Y = W_HT + SZ_ACT, W_RSS = W_Y + 2 * SZ_ACT,
                 W_CTR = W_RSS + (size_t)TP * 64, W_END = W_CTR + 256;
constexpr int LDS_BYTES = 131072;

struct Params {
    const float *x_prompt, *x_sample, *state_pool, *state_C, *state_n, *state_m, *meta, *norm1_w, *w_in, *b_if, *w_pool, *pool_scale, *mhln_w, *w_out, *normf_w;
    float* out;
    unsigned char* ws;
    int phase_lo, phase_hi;
};

DI int opaque_tid() { int t = threadIdx.x; asm volatile("" : "+v"(t)); return t; }
DI unsigned pk_bf16(float lo, float hi) { f2_t v = {lo, hi}; bf2_t r = __builtin_convertvector(v, bf2_t); return __builtin_bit_cast(unsigned, r); }
DI float bf_lo(unsigned u) { return __uint_as_float(u << 16); }
DI float bf_hi(unsigned u) { return __uint_as_float(u & 0xffff0000u); }
DI float bf2f(short s) { return __uint_as_float(((unsigned)(unsigned short)s) << 16); }
DI float wave_sum(float v) { for (int o = 32; o; o >>= 1) v += __shfl_xor(v, o); return v; }
DI float sigmoidf_(float x) { return __fdividef(1.f, 1.f + __expf(-x)); }
DI float siluf_(float x) { return x * sigmoidf_(x); }
DI f32x4 mfma16(bf16x8 a, bf16x8 b, f32x4 c) { return __builtin_amdgcn_mfma_f32_16x16x32_bf16(a, b, c, 0, 0, 0); }
DI s16x4 tr_read(const LAS unsigned char* a) { return __builtin_amdgcn_ds_read_tr16_b64_v4i16((LAS s16x4*)a); }
DI bf16x8 cat8(s16x4 lo, s16x4 hi) { return __builtin_shufflevector(lo, hi, 0, 1, 2, 3, 4, 5, 6, 7); }

DI const float* row_src(const Params& p, int r) {
    if (r < ROWS_P) { const int b = r / TPR, t = r - b * TPR; return t < NMETA ? p.meta + (size_t)t * DM : p.x_prompt + ((size_t)(b * SEQ + t - NMETA)) * DM; }
    return p.x_sample + (size_t)(r - ROWS_P) * DM;
}

DI void p0_rows(const Params& p, int u, LAS unsigned char* lds) {
    LAS float* Wg = (LAS float*)lds;
    const int tid = opaque_tid(), lane = tid & 63, wid = __builtin_amdgcn_readfirstlane(tid >> 6);
    for (int k = tid; k < 1024; k += 512) {
        const float4 a = *(const float4*)(p.w_in + (size_t)k * DPROJ + 7168);
        const float4 b = *(const float4*)(p.w_in + (size_t)k * DPROJ + 7172);
        Wg[0 * 1024 + k] = a.x; Wg[1 * 1024 + k] = a.y; Wg[2 * 1024 + k] = a.z; Wg[3 * 1024 + k] = a.w;
        Wg[4 * 1024 + k] = b.x; Wg[5 * 1024 + k] = b.y; Wg[6 * 1024 + k] = b.z; Wg[7 * 1024 + k] = b.w;
    }
    __syncthreads();
    bf16_t* XN = (bf16_t*)(p.ws + W_XN); float* GATES = (float*)(p.ws + W_GATES);
    for (int i = 0; i < 8; ++i) {
        const int r = u * 64 + wid * 8 + i;
        if (r >= T) { const u32x4 z = {0u, 0u, 0u, 0u}; *(u32x4*)(XN + (size_t)r * 1024 + lane * 16) = z; *(u32x4*)(XN + (size_t)r * 1024 + lane * 16 + 8) = z; continue; }
        const float* src = row_src(p, r);
        float4 x[4]; float ss = 0.f;
#pragma unroll
        for (int j = 0; j < 4; ++j) { x[j] = *(const float4*)(src + 4 * lane + 256 * j); ss += x[j].x * x[j].x + x[j].y * x[j].y + x[j].z * x[j].z + x[j].w * x[j].w; }
        ss = wave_sum(ss);
        const float rstd = rsqrtf(ss * (1.f / 1024.f) + 1e-6f);
        float ga[8];
#pragma unroll
        for (int g = 0; g < 8; ++g) ga[g] = 0.f;
#pragma unroll
        for (int j = 0; j < 4; ++j) {
            const float4 nw = *(const float4*)(p.norm1_w + 4 * lane + 256 * j);
            float4 y; y.x = x[j].x * rstd * nw.x; y.y = x[j].y * rstd * nw.y; y.z = x[j].z * rstd * nw.z; y.w = x[j].w * rstd * nw.w;
            u32x2 o; o.x = pk_bf16(y.x, y.y); o.y = pk_bf16(y.z, y.w);
            *(u32x2*)(XN + (size_t)r * 1024 + 4 * lane + 256 * j) = o;
#pragma unroll
            for (int g = 0; g < 8; ++g) { const f32x4 w = *(const LAS f32x4*)(Wg + g * 1024 + 4 * lane + 256 * j); ga[g] += y.x * w[0] + y.y * w[1] + y.z * w[2] + y.w * w[3]; }
        }
#pragma unroll
        for (int g = 0; g < 8; ++g) ga[g] = wave_sum(ga[g]);
        if (lane == 0) {
#pragma unroll
            for (int g = 0; g < 4; ++g) GATES[(size_t)r * 8 + g] = ga[g] + p.b_if[g];
#pragma unroll
            for (int g = 4; g < 8; ++g) { const float v = ga[g] + p.b_if[g]; GATES[(size_t)r * 8 + g] = fminf(v, 0.f) - log1pf(__expf(-fabsf(v))); }
        }
    }
    __syncthreads();
}

DI void p0_transpose(const float* src, int src_pitch, int cb0, int cb1, bool perm, float scale, bf16_t* dst, int dst_pitch, int k0, LAS unsigned char* lds) {
    LAS float* tile = (LAS float*)lds;
    const int tid = opaque_tid();
    const int c4 = (tid & 63) * 4, r0 = tid >> 6;
    const int scol = c4 < 128 ? cb0 + c4 : cb1 + c4 - 128;
#pragma unroll
    for (int i = 0; i < 8; ++i) { const int row = r0 + 8 * i; const float4 v = *(const float4*)(src + (size_t)(k0 + row) * src_pitch + scol);
        tile[row * 257 + c4 + 0] = v.x; tile[row * 257 + c4 + 1] = v.y; tile[row * 257 + c4 + 2] = v.z; tile[row * 257 + c4 + 3] = v.w; }
    __syncthreads();
    const int kg = tid & 7;
#pragma unroll
    for (int i = 0; i < 4; ++i) {
        const int r = (tid >> 3) + 64 * i;
        const int c = perm ? ((r & ~31) + pg8::perm32(r & 31)) : r;
        float v[8];
#pragma unroll
        for (int j = 0; j < 8; ++j) v[j] = tile[(kg * 8 + j) * 257 + c] * scale;
        u32x4 o; o.x = pk_bf16(v[0], v[1]); o.y = pk_bf16(v[2], v[3]); o.z = pk_bf16(v[4], v[5]); o.w = pk_bf16(v[6], v[7]);
        *(u32x4*)(dst + (size_t)r * dst_pitch + k0 + kg * 8) = o;
    }
    __syncthreads();
}

constexpr int NU0_ROWS = TP / 64  , NU0_WIN = 28 * 16, NU0_WOUT = 4 * 32, NU0_WPOOL = 4 * 4, NU0 = NU0_ROWS + NU0_WIN + NU0_WOUT + NU0_WPOOL;
DI void phase0(const Params& p, LAS unsigned char* lds) {
    if (blockIdx.x == 0 && threadIdx.x == 0) *(unsigned*)(p.ws + W_CTR) = 0u;
    for (int u = blockIdx.x; u < NU0; u += gridDim.x) {
        if (u < NU0_ROWS) p0_rows(p, u, lds);
        else if (u < NU0_ROWS + NU0_WIN) { const int i = u - NU0_ROWS, pn = i >> 4, kb = i & 15;
            const int cb0 = pn < 20 ? 256 * pn : 5120 + 128 * (pn - 20), cb1 = pn < 20 ? 256 * pn + 128 : 6144 + 128 * (pn - 20);
            p0_transpose(p.w_in, DPROJ, cb0, cb1, true, (pn >= 12 && pn < 16) ? 0.0625f : 1.f, (bf16_t*)(p.ws + W_WIN) + (size_t)pn * 256 * 1024, 1024, 64 * kb, lds); }
        else if (u < NU0_ROWS + NU0_WIN + NU0_WOUT) { const int i = u - NU0_ROWS - NU0_WIN, pn = i >> 5, kb = i & 31;
            p0_transpose(p.w_out, 1024, 256 * pn, 256 * pn + 128, false, 1.f, (bf16_t*)(p.ws + W_WOUT) + (size_t)pn * 256 * 2048, 2048, 64 * kb, lds); }
        else { const int i = u - NU0_ROWS - NU0_WIN - NU0_WOUT, g = i >> 2, kb = i & 3;
            p0_transpose(p.w_pool + (size_t)g * 65536, 256, 0, 128, false, 1.f, (bf16_t*)(p.ws + W_WPOOL) + (size_t)g * 65536, 256, 64 * kb, lds); }
    }
}

struct EpiG1 {
    static constexpr bool PERM = false, AFTER_DRAIN = false;
    bf16_t *U, *ZA, *Q, *K, *V, *G; const float* pool_scale;
    DI void operator()(const f32x4 (&acc)[2][2][4][2], const Unit& u, int wr, int wc, int fr, int fq) const {
        const int row0 = u.pm * 256 + wr * 64 + fr, cl = wc * 32 + 8 * fq;
        if (u.pn >= 20) {
            const int col = (u.pn - 20) * 128 + cl;
#pragma unroll
            for (int ai = 0; ai < 2; ++ai)
#pragma unroll
                for (int m = 0; m < 4; ++m) {
                    const int row = row0 + ai * 128 + m * 16;
                    float r[8];
#pragma unroll
                    for (int i = 0; i < 4; ++i) { r[i] = sigmoidf_(acc[ai][0][m][0][i]) * siluf_(acc[ai][1][m][0][i]); r[4 + i] = sigmoidf_(acc[ai][0][m][1][i]) * siluf_(acc[ai][1][m][1][i]); }
                    u32x4 o; o.x = pk_bf16(r[0], r[1]); o.y = pk_bf16(r[2], r[3]); o.z = pk_bf16(r[4], r[5]); o.w = pk_bf16(r[6], r[7]);
                    *(u32x4*)(G + (size_t)row * 1024 + col) = o;
                }
        } else {
            const int tsel = u.pn >> 2;
            bf16_t* base = tsel == 0 ? U : tsel == 1 ? ZA : tsel == 2 ? Q : tsel == 3 ? K : V;
#pragma unroll
            for (int bj = 0; bj < 2; ++bj) {
                const int col = (u.pn & 3) * 256 + bj * 128 + cl;
                float ps[8];
                if (tsel == 1) { const float4 a = *(const float4*)(pool_scale + col), b = *(const float4*)(pool_scale + col + 4); ps[0] = a.x; ps[1] = a.y; ps[2] = a.z; ps[3] = a.w; ps[4] = b.x; ps[5] = b.y; ps[6] = b.z; ps[7] = b.w; }
#pragma unroll
                for (int ai = 0; ai < 2; ++ai)
#pragma unroll
                    for (int m = 0; m < 4; ++m) {
                        const int row = row0 + ai * 128 + m * 16;
                        float r[8];
#pragma unroll
                        for (int i = 0; i < 4; ++i) { r[i] = acc[ai][bj][m][0][i]; r[4 + i] = acc[ai][bj][m][1][i]; }
                        if (tsel == 1) {
#pragma unroll
                            for (int i = 0; i < 8; ++i) r[i] = siluf_(r[i]) * ps[i];
                        }
                        u32x4 o; o.x = pk_bf16(r[0], r[1]); o.y = pk_bf16(r[2], r[3]); o.z = pk_bf16(r[4], r[5]); o.w = pk_bf16(r[6], r[7]);
                        *(u32x4*)(base + (size_t)row * 1024 + col) = o;
                    }
            }
        }
    }
};

struct EpiG2 {
    static constexpr bool PERM = false, AFTER_DRAIN = false;
    const float* x_prompt; long xs_delta; float* out; float* rss;
    DI void operator()(const f32x4 (&acc)[2][2][4][2], const Unit& u, int wr, int wc, int fr, int fq) const {
        const int row0 = u.pm * 256 + wr * 64 + fr, col0 = u.pn * 256 + wc * 32 + 4 * fq;
#pragma unroll
        for (int ai = 0; ai < 2; ++ai)
#pragma unroll
            for (int m = 0; m < 4; ++m) {
                const int row = row0 + ai * 128 + m * 16;
                bool valid = row < T; long off = 0, xoff = 0;
                if (row < ROWS_P) { const int b = row / TPR, t = row - b * TPR; valid = t >= NMETA; off = ((long)(b * SEQ + t - NMETA)) * 1024; xoff = off; }
                else { off = (long)O_YS + (long)(row - ROWS_P) * 1024; xoff = xs_delta + (long)(row - ROWS_P) * 1024; }
                const float* xin = x_prompt + xoff; float* yo = out + off;
                float ss = 0.f;
                if (valid) {
#pragma unroll
                    for (int bj = 0; bj < 2; ++bj)
#pragma unroll
                        for (int n = 0; n < 2; ++n) {
                            const int c = col0 + bj * 128 + n * 16;
                            const f32x4 xv = *(const f32x4*)(xin + c);
                            const f32x4 v = acc[ai][bj][m][n] + xv;
                            *(f32x4*)(yo + c) = v;
                            ss += v[0] * v[0] + v[1] * v[1] + v[2] * v[2] + v[3] * v[3];
                        }
                }
                ss += __shfl_xor(ss, 16); ss += __shfl_xor(ss, 32);
                if (valid && fq == 0) rss[(size_t)row * 16 + u.pn * 4 + wc] = ss;
            }
    }
};

constexpr int L_Q = 0, L_K = 33792, L_V = 67584, L_SW = 84992, L_AL = 94208, L_GG = 102656, L_MM = 111104, L_MP = 119552, L_NV = 119808,
              L_QD = 120832, L_DEN = 121088, L_WE = 121344, L_BL = 121600, L_PL = 121856, L_CTL = 122112;
constexpr int QST = 528, VST = 272, SST = 144;

DI void scan_unit(const Params& p, const bool sample, const int b, const int h, const int eh, LAS unsigned char* lds) {
    const int tid = opaque_tid(), lane = tid & 63, wid = __builtin_amdgcn_readfirstlane(tid >> 6), fr = lane & 15, fq = lane >> 4;
    const int nch = sample ? 1 : 33;
    const int rowbase = sample ? ROWS_P + b * 8 : b * TPR;
    const int ecol = h * 256 + eh * 128, e0 = 16 * wid;
    LAS float* AL = (LAS float*)(lds + L_AL); LAS float* GG = (LAS float*)(lds + L_GG); LAS float* MM = (LAS float*)(lds + L_MM); LAS float* MP = (LAS float*)(lds + L_MP);
    LAS float* NV = (LAS float*)(lds + L_NV); LAS float* QD = (LAS float*)(lds + L_QD); LAS float* DEN = (LAS float*)(lds + L_DEN); LAS float* WE = (LAS float*)(lds + L_WE);
    LAS float* BL = (LAS float*)(lds + L_BL); LAS float* PL = (LAS float*)(lds + L_PL);
    const float* GATES = (const float*)(p.ws + W_GATES);
    const bf16_t* Qg = (const bf16_t*)(p.ws + W_Q); const bf16_t* Kg = (const bf16_t*)(p.ws + W_K); const bf16_t* Vg = (const bf16_t*)(p.ws + W_V);
    bf16_t* HT = (bf16_t*)(p.ws + W_HT);
    const int npos = nch * 64;
    __syncthreads();
    for (int idx = tid; idx < npos; idx += 512) {
        const int c = idx >> 6, i = idx & 63;
        const int L = sample ? 8 : (c == 0 ? 16 : 64);
        const int t = sample ? i : (c == 0 ? i : 16 + 64 * (c - 1) + i);
        float lf = 0.f, ig = -INFINITY;
        if (i < L) { const float* g = GATES + (size_t)(rowbase + t) * 8; ig = g[h]; lf = g[4 + h]; }
        AL[idx] = lf; GG[idx] = ig;
    }
    if (tid < 256) NV[tid] = sample ? p.state_n[((size_t)b * 4 + h) * 256 + tid] : 0.f;
    __syncthreads();
    if (tid < nch) {
        const int c = tid; const int L = sample ? 8 : (c == 0 ? 16 : 64);
        float bs = 0.f, P = -INFINITY;
        for (int i = 0; i < L; ++i) { const int idx = c * 64 + i; bs += AL[idx]; const float g = GG[idx] - bs; P = fmaxf(P, g); AL[idx] = bs; GG[idx] = g; MM[idx] = P; }
        BL[c] = bs; PL[c] = P;
    }
    __syncthreads();
    if (tid == 0) { float m = sample ? p.state_m[b * 4 + h] : 0.f; MP[0] = m; for (int c = 0; c < nch; ++c) { m = BL[c] + fmaxf(m, PL[c]); MP[c + 1] = m; } }
    __syncthreads();
    for (int idx = tid; idx < npos; idx += 512) {
        const int c = idx >> 6, i = idx & 63;
        const int L = sample ? 8 : (c == 0 ? 16 : 64);
        if (i < L) { const float bt = AL[idx]; const float mt = bt + fmaxf(MP[c], MM[idx]); AL[idx] = bt - mt; MM[idx] = mt; }
        else { AL[idx] = 0.f; MM[idx] = 0.f; }
    }
    f32x4 C[16];
    if (sample) {
        const float* Cs = p.state_C + (((size_t)b * 4 + h) * 256) * 256 + eh * 128 + e0 + fr;
#pragma unroll
        for (int i = 0; i < 16; ++i)
#pragma unroll
            for (int j = 0; j < 4; ++j) C[i][j] = Cs[(size_t)(16 * i + 4 * fq + j) * 256];
    } else {
#pragma unroll
        for (int i = 0; i < 16; ++i) C[i] = (f32x4){0.f, 0.f, 0.f, 0.f};
    }
    for (int c = 0; c < nch; ++c) {
        const int L = sample ? 8 : (c == 0 ? 16 : 64);
        const int t0 = sample ? 0 : (c == 0 ? 0 : 16 + 64 * (c - 1));
        const int gi = c * 64;
        __syncthreads();
        {
            const int r = tid >> 3, seg = tid & 7;
            const size_t grow = (size_t)(rowbase + t0 + r) * 1024;
            const u32x4 z = {0u, 0u, 0u, 0u};
#pragma unroll
            for (int i = 0; i < 4; ++i) { const int c16 = seg + 8 * i; u32x4 q = z, k = z;
                if (r < L) { q = *(const u32x4*)(Qg + grow + h * 256 + c16 * 8); k = *(const u32x4*)(Kg + grow + h * 256 + c16 * 8); }
                *(LAS u32x4*)(lds + L_Q + r * QST + c16 * 16) = q; *(LAS u32x4*)(lds + L_K + r * QST + c16 * 16) = k; }
#pragma unroll
            for (int i = 0; i < 2; ++i) { const int c16 = seg + 8 * i; u32x4 v = z;
                if (r < L) v = *(const u32x4*)(Vg + grow + ecol + c16 * 8);
                *(LAS u32x4*)(lds + L_V + r * VST + c16 * 16) = v; }
        }
        __syncthreads();
        {
            const int t = tid >> 3, part = tid & 7; float s = 0.f;
#pragma unroll
            for (int i = 0; i < 4; ++i) { const bf16x8 q = *(const LAS bf16x8*)(lds + L_Q + t * QST + (part * 4 + i) * 16);
#pragma unroll
                for (int j = 0; j < 8; ++j) s += bf2f(q[j]) * NV[32 * part + 8 * i + j]; }
            s += __shfl_xor(s, 1); s += __shfl_xor(s, 2); s += __shfl_xor(s, 4);
            if (part == 0) QD[t] = s;
        }
        {
            const int tt = wid >> 1;
#pragma unroll
            for (int si = 0; si < 2; ++si) {
                const int st = 2 * (wid & 1) + si;
                u32x2 outv = {0u, 0u};
                if (st <= tt) {
                    f32x4 a = {0.f, 0.f, 0.f, 0.f};
#pragma unroll
                    for (int kk = 0; kk < 8; ++kk) {
                        const bf16x8 ak = *(const LAS bf16x8*)(lds + L_K + (16 * st + fr) * QST + (kk * 32 + fq * 8) * 2);
                        const bf16x8 bq = *(const LAS bf16x8*)(lds + L_Q + (16 * tt + fr) * QST + (kk * 32 + fq * 8) * 2);
                        a = mfma16(ak, bq, a);
                    }
                    const int t = 16 * tt + fr; const float al = AL[gi + t];
                    const f32x4 g4 = *(const LAS f32x4*)(GG + gi + 16 * st + 4 * fq);
                    float w[4];
#pragma unroll
                    for (int j = 0; j < 4; ++j) { const int s = 16 * st + 4 * fq + j; w[j] = (s <= t) ? a[j] * __expf(al + g4[j]) : 0.f; }
                    outv.x = pk_bf16(w[0], w[1]); outv.y = pk_bf16(w[2], w[3]);
                }
                *(LAS u32x2*)(lds + L_SW + (16 * tt + fr) * SST + (16 * st + 4 * fq) * 2) = outv;
            }
        }
        f32x4 num[4];
#pragma unroll
        for (int mt = 0; mt < 4; ++mt) num[mt] = (f32x4){0.f, 0.f, 0.f, 0.f};
#pragma unroll
        for (int kk = 0; kk < 8; ++kk) {
            u32x4 bc; bc.x = pk_bf16(C[2 * kk][0], C[2 * kk][1]); bc.y = pk_bf16(C[2 * kk][2], C[2 * kk][3]); bc.z = pk_bf16(C[2 * kk + 1][0], C[2 * kk + 1][1]); bc.w = pk_bf16(C[2 * kk + 1][2], C[2 * kk + 1][3]);
            const bf16x8 bfrag = __builtin_bit_cast(bf16x8, bc);
#pragma unroll
            for (int mt = 0; mt < 4; ++mt) {
                const s16x4 lo = *(const LAS s16x4*)(lds + L_Q + (16 * mt + fr) * QST + (32 * kk + 4 * fq) * 2);
                const s16x4 hi = *(const LAS s16x4*)(lds + L_Q + (16 * mt + fr) * QST + (32 * kk + 16 + 4 * fq) * 2);
                num[mt] = mfma16(cat8(lo, hi), bfrag, num[mt]);
            }
        }
        __syncthreads();
        const float mprev = MP[c];
        const float alast = AL[gi + L - 1];
        const float decay = __expf(alast + mprev);
        if (tid < 64) {
            const int t = tid; float rs = 0.f;
#pragma unroll
            for (int i = 0; i < 8; ++i) { const bf16x8 v = *(const LAS bf16x8*)(lds + L_SW + t * SST + i * 16);
#pragma unroll
                for (int j = 0; j < 8; ++j) rs += bf2f(v[j]); }
            const float inter = __expf(AL[gi + t] + mprev);
            DEN[t] = __fdividef(1.f, fmaxf(fabsf(inter * QD[t] + rs), __expf(-MM[gi + t])));
            WE[t] = __expf(alast + GG[gi + t]);
        }
#pragma unroll
        for (int mt = 0; mt < 4; ++mt) { const f32x4 a4 = *(const LAS f32x4*)(AL + gi + 16 * mt + 4 * fq);
#pragma unroll
            for (int j = 0; j < 4; ++j) num[mt][j] *= __expf(a4[j] + mprev); }
        bf16x8 vb[2], vw[2];
#pragma unroll
        for (int kk = 0; kk < 2; ++kk) {
            const LAS unsigned char* base = lds + L_V + (32 * kk + 8 * fq + (fr >> 2)) * VST + (e0 + 4 * (fr & 3)) * 2;
            vb[kk] = cat8(tr_read(base), tr_read(base + 4 * VST));
            const f32x4 g0 = *(const LAS f32x4*)(GG + gi + 32 * kk + 8 * fq), g1 = *(const LAS f32x4*)(GG + gi + 32 * kk + 8 * fq + 4);
            float f[8];
#pragma unroll
            for (int j = 0; j < 4; ++j) { f[j] = bf2f(vb[kk][j]) * __expf(alast + g0[j]); f[4 + j] = bf2f(vb[kk][4 + j]) * __expf(alast + g1[j]); }
            u32x4 o; o.x = pk_bf16(f[0], f[1]); o.y = pk_bf16(f[2], f[3]); o.z = pk_bf16(f[4], f[5]); o.w = pk_bf16(f[6], f[7]);
            vw[kk] = __builtin_bit_cast(bf16x8, o);
        }
#pragma unroll
        for (int mt = 0; mt < 4; ++mt)
#pragma unroll
            for (int kk = 0; kk < 2; ++kk)
                if (kk == 0 || mt >= 2) { const bf16x8 a = *(const LAS bf16x8*)(lds + L_SW + (16 * mt + fr) * SST + (32 * kk + 8 * fq) * 2); num[mt] = mfma16(a, vb[kk], num[mt]); }
#pragma unroll
        for (int i = 0; i < 16; ++i) {
            C[i] *= decay;
#pragma unroll
            for (int kk = 0; kk < 2; ++kk) {
                const LAS unsigned char* base = lds + L_K + (32 * kk + 8 * fq + (fr >> 2)) * QST + (16 * i + 4 * (fr & 3)) * 2;
                C[i] = mfma16(cat8(tr_read(base), tr_read(base + 4 * QST)), vw[kk], C[i]);
            }
        }
        __syncthreads();
        {
            const int dp = tid >> 2, sq = tid & 3; float a0 = 0.f, a1 = 0.f;
#pragma unroll
            for (int i = 0; i < 16; ++i) { const int s = i * 4 + sq; const unsigned kk = *(const LAS unsigned*)(lds + L_K + s * QST + dp * 4); const float w = WE[s]; a0 += w * bf_lo(kk); a1 += w * bf_hi(kk); }
            a0 += __shfl_xor(a0, 1); a0 += __shfl_xor(a0, 2); a1 += __shfl_xor(a1, 1); a1 += __shfl_xor(a1, 2);
            if (sq == 0) { NV[2 * dp] = decay * NV[2 * dp] + a0; NV[2 * dp + 1] = decay * NV[2 * dp + 1] + a1; }
        }
#pragma unroll
        for (int mt = 0; mt < 4; ++mt) { const f32x4 dn = *(const LAS f32x4*)(DEN + 16 * mt + 4 * fq);
#pragma unroll
            for (int j = 0; j < 4; ++j) { const int t = 16 * mt + 4 * fq + j;
                if (t < L) HT[(size_t)(rowbase + t0 + t) * 1024 + ecol + e0 + fr] = (bf16_t)(pk_bf16(num[mt][j] * dn[j], 0.f) & 0xffffu); } }
    }
    float* Cout = p.out + (sample ? O_CS : O_CP) + (((size_t)b * 4 + h) * 256) * 256 + eh * 128 + e0 + fr;
#pragma unroll
    for (int i = 0; i < 16; ++i)
#pragma unroll
        for (int j = 0; j < 4; ++j) Cout[(size_t)(16 * i + 4 * fq + j) * 256] = C[i][j];
    __syncthreads();
    if (eh == 0) {
        if (tid < 256) (p.out + (sample ? O_NS : O_NP))[((size_t)b * 4 + h) * 256 + tid] = NV[tid];
        if (tid == 0) (p.out + (sample ? O_MS : O_MP))[b * 4 + h] = MP[nch];
    }
}

DI void pool_unit(const Params& p, const int tile, const int g, LAS unsigned char* lds) {
    const int tid = opaque_tid(), lane = tid & 63, wid = __builtin_amdgcn_readfirstlane(tid >> 6), fr = lane & 15, fq = lane >> 4;
    const int w = 2 << g;
    const bf16_t* U = (const bf16_t*)(p.ws + W_U); const bf16_t* ZA = (const bf16_t*)(p.ws + W_ZA); bf16_t* Y = (bf16_t*)(p.ws + W_Y);
    __syncthreads();
    for (int it = 0; it < 4; ++it) {
        const int item = tid + 512 * it, r = item >> 5, cg8 = item & 31;
        const int row = tile * 64 + r, ch = 256 * g + 8 * cg8;
        const bool sample = row >= ROWS_P;
        int b, t, cnt;
        if (!sample) { b = row / TPR; t = row - b * TPR; cnt = min(w, t + 1); } else { const int si = row - ROWS_P; b = si >> 3; t = si & 7; cnt = w; }
        float s[8], cur[8];
#pragma unroll
        for (int i = 0; i < 8; ++i) { s[i] = 0.f; cur[i] = 0.f; }
        for (int j = 0; j < w; ++j) {
            if (j <= t) {
                const u32x4 v = *(const u32x4*)(U + (size_t)(row - j) * 1024 + ch);
                const float f0 = bf_lo(v.x), f1 = bf_hi(v.x), f2 = bf_lo(v.y), f3 = bf_hi(v.y), f4 = bf_lo(v.z), f5 = bf_hi(v.z), f6 = bf_lo(v.w), f7 = bf_hi(v.w);
                s[0] += f0; s[1] += f1; s[2] += f2; s[3] += f3; s[4] += f4; s[5] += f5; s[6] += f6; s[7] += f7;
                if (j == 0) { cur[0] = f0; cur[1] = f1; cur[2] = f2; cur[3] = f3; cur[4] = f4; cur[5] = f5; cur[6] = f6; cur[7] = f7; }
            } else if (sample) {
                const float* sp = p.state_pool + ((size_t)b * 15 + (15 + t - j)) * 1024 + ch;
                const float4 a = *(const float4*)sp, c4 = *(const float4*)(sp + 4);
                s[0] += a.x; s[1] += a.y; s[2] += a.z; s[3] += a.w; s[4] += c4.x; s[5] += c4.y; s[6] += c4.z; s[7] += c4.w;
            }
        }
        const float inv = 1.f / (float)cnt;
        u32x4 o; o.x = pk_bf16(s[0] * inv - cur[0], s[1] * inv - cur[1]); o.y = pk_bf16(s[2] * inv - cur[2], s[3] * inv - cur[3]);
        o.z = pk_bf16(s[4] * inv - cur[4], s[5] * inv - cur[5]); o.w = pk_bf16(s[6] * inv - cur[6], s[7] * inv - cur[7]);
        *(LAS u32x4*)(lds + L_Q + r * QST + cg8 * 16) = o;
    }
    __syncthreads();
    f32x4 acc[4][2];
#pragma unroll
    for (int mt = 0; mt < 4; ++mt) { acc[mt][0] = (f32x4){0.f, 0.f, 0.f, 0.f}; acc[mt][1] = (f32x4){0.f, 0.f, 0.f, 0.f}; }
    const bf16_t* Wp = (const bf16_t*)(p.ws + W_WPOOL) + (size_t)g * 65536;
#pragma unroll
    for (int kk = 0; kk < 8; ++kk) {
        bf16x8 bw[2];
#pragma unroll
        for (int n = 0; n < 2; ++n) bw[n] = *(const bf16x8*)(Wp + (size_t)(32 * wid + 16 * n + fr) * 256 + 32 * kk + 8 * fq);
#pragma unroll
        for (int mt = 0; mt < 4; ++mt) {
            const bf16x8 a = *(const LAS bf16x8*)(lds + L_Q + (16 * mt + fr) * QST + (32 * kk + 8 * fq) * 2);
#pragma unroll
            for (int n = 0; n < 2; ++n) acc[mt][n] = mfma16(bw[n], a, acc[mt][n]);
        }
    }
#pragma unroll
    for (int mt = 0; mt < 4; ++mt) {
        const int row = tile * 64 + 16 * mt + fr;
#pragma unroll
        for (int n = 0; n < 2; ++n) {
            const int d = 256 * g + 32 * wid + 16 * n + 4 * fq;
            const u32x2 za = *(const u32x2*)(ZA + (size_t)row * 1024 + d);
            u32x2 o; o.x = pk_bf16(acc[mt][n][0] * bf_lo(za.x), acc[mt][n][1] * bf_hi(za.x)); o.y = pk_bf16(acc[mt][n][2] * bf_lo(za.y), acc[mt][n][3] * bf_hi(za.y));
            *(u32x2*)(Y + (size_t)row * 2048 + d) = o;
        }
    }
}

constexpr int N_ITEMS2 = 2048 + 72;
DI void phase2(const Params& p, LAS unsigned char* lds) {
    for (int u = blockIdx.x; u < 64; u += gridDim.x) { const int eh = (u >> 3) & 1, bh = (u & 7) + 8 * (u >> 4); scan_unit(p, false, bh >> 2, bh & 3, eh, lds); }
    unsigned* ctr = (unsigned*)(p.ws + W_CTR);
    for (;;) {
        __syncthreads();
        if (threadIdx.x == 0) *(LAS int*)(lds + L_CTL) = (int)atomicAdd(ctr, 1u);
        __syncthreads();
        const int item = *(const LAS int*)(lds + L_CTL);
        if (item >= N_ITEMS2) break;
        if (item < 2048 && !(item & 1)) { const int su = item >> 1; scan_unit(p, true, su >> 3, (su >> 1) & 3, su & 1, lds); }
        else { const int pt = item < 2048 ? (item >> 1) : 1024 + (item - 2048); pool_unit(p, pt >> 2, pt & 3, lds); }
    }
}

DI void phase3(const Params& p) {
    const int tid = opaque_tid(), lane = tid & 63, wid = __builtin_amdgcn_readfirstlane(tid >> 6);
    const bf16_t* HT = (const bf16_t*)(p.ws + W_HT); const bf16_t* G = (const bf16_t*)(p.ws + W_G); const bf16_t* U = (const bf16_t*)(p.ws + W_U); bf16_t* Y = (bf16_t*)(p.ws + W_Y);
    for (int r = blockIdx.x * 8 + wid; r < T; r += gridDim.x * 8) {
        const int ch = 16 * lane;
        const u32x4 h0 = *(const u32x4*)(HT + (size_t)r * 1024 + ch), h1 = *(const u32x4*)(HT + (size_t)r * 1024 + ch + 8);
        float v[16] = {bf_lo(h0.x), bf_hi(h0.x), bf_lo(h0.y), bf_hi(h0.y), bf_lo(h0.z), bf_hi(h0.z), bf_lo(h0.w), bf_hi(h0.w),
                       bf_lo(h1.x), bf_hi(h1.x), bf_lo(h1.y), bf_hi(h1.y), bf_lo(h1.z), bf_hi(h1.z), bf_lo(h1.w), bf_hi(h1.w)};
        float s = 0.f;
#pragma unroll
        for (int i = 0; i < 16; ++i) s += v[i];
        s += __shfl_xor(s, 1); s += __shfl_xor(s, 2); s += __shfl_xor(s, 4); s += __shfl_xor(s, 8);
        const float mu = s * (1.f / 256.f);
        float q = 0.f;
#pragma unroll
        for (int i = 0; i < 16; ++i) { v[i] -= mu; q += v[i] * v[i]; }
        q += __shfl_xor(q, 1); q += __shfl_xor(q, 2); q += __shfl_xor(q, 4); q += __shfl_xor(q, 8);
        const float rstd = rsqrtf(q * (1.f / 256.f) + 1e-6f);
        const u32x4 g0 = *(const u32x4*)(G + (size_t)r * 1024 + ch), g1 = *(const u32x4*)(G + (size_t)r * 1024 + ch + 8);
        const float gg[16] = {bf_lo(g0.x), bf_hi(g0.x), bf_lo(g0.y), bf_hi(g0.y), bf_lo(g0.z), bf_hi(g0.z), bf_lo(g0.w), bf_hi(g0.w),
                              bf_lo(g1.x), bf_hi(g1.x), bf_lo(g1.y), bf_hi(g1.y), bf_lo(g1.z), bf_hi(g1.z), bf_lo(g1.w), bf_hi(g1.w)};
        float o[16];
#pragma unroll
        for (int i = 0; i < 4; ++i) { const float4 w4 = *(const float4*)(p.mhln_w + ch + 4 * i);
            o[4 * i] = v[4 * i] * rstd * w4.x * gg[4 * i]; o[4 * i + 1] = v[4 * i + 1] * rstd * w4.y * gg[4 * i + 1];
            o[4 * i + 2] = v[4 * i + 2] * rstd * w4.z * gg[4 * i + 2]; o[4 * i + 3] = v[4 * i + 3] * rstd * w4.w * gg[4 * i + 3]; }
        u32x4 a, c;
        a.x = pk_bf16(o[0], o[1]); a.y = pk_bf16(o[2], o[3]); a.z = pk_bf16(o[4], o[5]); a.w = pk_bf16(o[6], o[7]);
        c.x = pk_bf16(o[8], o[9]); c.y = pk_bf16(o[10], o[11]); c.z = pk_bf16(o[12], o[13]); c.w = pk_bf16(o[14], o[15]);
        *(u32x4*)(Y + (size_t)r * 2048 + 1024 + ch) = a; *(u32x4*)(Y + (size_t)r * 2048 + 1024 + ch + 8) = c;
    }
    const size_t gtid = (size_t)blockIdx.x * 512 + tid, gstr = (size_t)gridDim.x * 512;
    for (size_t i = gtid; i < (size_t)122880; i += gstr) { const int c = (int)(i & 1023), ri = (int)(i >> 10), b = ri / 15, k = ri - b * 15;
        p.out[O_PP + i] = __uint_as_float(((unsigned)U[(size_t)(b * TPR + 2049 + k) * 1024 + c]) << 16); }
    for (size_t i = gtid; i < (size_t)1966080; i += gstr) { const int c = (int)(i & 1023), ri = (int)(i >> 10), b = ri / 15, k = ri - b * 15;
        p.out[O_PS + i] = k < 7 ? p.state_pool[((size_t)b * 15 + 8 + k) * 1024 + c] : __uint_as_float(((unsigned)U[(size_t)(ROWS_P + b * 8 + k - 7) * 1024 + c]) << 16); }
}

DI void phase5(const Params& p) {
    const int tid = opaque_tid(), lane = tid & 63, wid = __builtin_amdgcn_readfirstlane(tid >> 6);
    const float* rss = (const float*)(p.ws + W_RSS);
    for (int o = blockIdx.x * 8 + wid; o < 16384 + 1024; o += gridDim.x * 8) {
        const int R = o < 16384 ? (o >> 11) * TPR + (o & 2047) + NMETA : ROWS_P + (o - 16384);
        float s = lane < 16 ? rss[(size_t)R * 16 + lane] : 0.f;
        s += __shfl_xor(s, 1); s += __shfl_xor(s, 2); s += __shfl_xor(s, 4); s += __shfl_xor(s, 8);
        s = __shfl(s, 0);
        const float rstd = rsqrtf(s * (1.f / 1024.f) + 1e-6f);
        float* row = p.out + (size_t)o * 1024;
#pragma unroll
        for (int j = 0; j < 4; ++j) { float4 v = *(float4*)(row + 4 * lane + 256 * j); const float4 w = *(const float4*)(p.normf_w + 4 * lane + 256 * j);
            v.x *= rstd * w.x; v.y *= rstd * w.y; v.z *= rstd * w.z; v.w *= rstd * w.w; *(float4*)(row + 4 * lane + 256 * j) = v; }
    }
}

DI void run_phase(const Params& p, int ph, LAS unsigned char* lds) {
    if (ph == 0) phase0(p, lds);
    else if (ph == 1) {
        pg8::Gemm g; g.A = (const bf16_t*)(p.ws + W_XN); g.Bt = (const bf16_t*)(p.ws + W_WIN); g.M = TP; g.N = 7168; g.K = 1024;
        pg8::StaticOrder S; S.init(g.M, g.N, (int)gridDim.x, (int)blockIdx.x);
        EpiG1 E; E.U = (bf16_t*)(p.ws + W_U); E.ZA = (bf16_t*)(p.ws + W_ZA); E.Q = (bf16_t*)(p.ws + W_Q); E.K = (bf16_t*)(p.ws + W_K); E.V = (bf16_t*)(p.ws + W_V); E.G = (bf16_t*)(p.ws + W_G); E.pool_scale = p.pool_scale;
        pg8::gemm_phase<EpiG1, pg8::StaticOrder, false>(lds, g, S, E, nullptr);
    } else if (ph == 2) phase2(p, lds);
    else if (ph == 3) phase3(p);
    else if (ph == 4) {
        pg8::Gemm g; g.A = (const bf16_t*)(p.ws + W_Y); g.Bt = (const bf16_t*)(p.ws + W_WOUT); g.M = TP; g.N = 1024; g.K = 2048;
        pg8::StaticOrder S; S.init(g.M, g.N, (int)gridDim.x, (int)blockIdx.x);
        EpiG2 E; E.x_prompt = p.x_prompt; E.xs_delta = (long)(p.x_sample - p.x_prompt); E.out = p.out; E.rss = (float*)(p.ws + W_RSS);
        pg8::gemm_phase<EpiG2, pg8::StaticOrder, false>(lds, g, S, E, nullptr);
    } else phase5(p);
}

template <bool COOP, int PH> __global__ __launch_bounds__(512, 2) void hymba_mega(Params p) {
    extern __shared__ __attribute__((aligned(16))) unsigned char smem[];
    LAS unsigned char* lds = (LAS unsigned char*)smem;
    if constexpr (COOP) {
        cg::grid_group grid = cg::this_grid();
        run_phase(p, 0, lds); grid.sync(); run_phase(p, 1, lds); grid.sync(); run_phase(p, 2, lds); grid.sync();
        run_phase(p, 3, lds); grid.sync(); run_phase(p, 4, lds); grid.sync(); run_phase(p, 5, lds);
    } else {
        run_phase(p, PH, lds);
    }
}

extern "C" void kernel_launch(void* const* d_in, const int* in_sizes, int n_in, void* d_out, int out_size, void* d_ws, size_t ws_size, hipStream_t stream) {
    (void)in_sizes; (void)n_in; (void)out_size; (void)ws_size;
    Params p{};
    p.x_prompt = (const float*)d_in[0]; p.x_sample = (const float*)d_in[1]; p.state_pool = (const float*)d_in[2]; p.state_C = (const float*)d_in[3];
    p.state_n = (const float*)d_in[4]; p.state_m = (const float*)d_in[5]; p.meta = (const float*)d_in[6]; p.norm1_w = (const float*)d_in[7];
    p.w_in = (const float*)d_in[8]; p.b_if = (const float*)d_in[9]; p.w_pool = (const float*)d_in[10]; p.pool_scale = (const float*)d_in[11];
    p.mhln_w = (const float*)d_in[12]; p.w_out = (const float*)d_in[13]; p.normf_w = (const float*)d_in[14];
    p.out = (float*)d_out; p.ws = (unsigned char*)d_ws;
    static int grid_blocks = 0;
    if (!grid_blocks) {
        int dev = 0, cus = 0, per_cu = 0;
        (void)hipGetDevice(&dev);
        (void)hipDeviceGetAttribute(&cus, hipDeviceAttributeMultiprocessorCount, dev);
#if MK_MULTI
        (void)hipFuncSetAttribute((const void*)hymba_mega<false, 0>, hipFuncAttributeMaxDynamicSharedMemorySize, LDS_BYTES);
        (void)hipFuncSetAttribute((const void*)hymba_mega<false, 1>, hipFuncAttributeMaxDynamicSharedMemorySize, LDS_BYTES);
        (void)hipFuncSetAttribute((const void*)hymba_mega<false, 2>, hipFuncAttributeMaxDynamicSharedMemorySize, LDS_BYTES);
        (void)hipFuncSetAttribute((const void*)hymba_mega<false, 3>, hipFuncAttributeMaxDynamicSharedMemorySize, LDS_BYTES);
        (void)hipFuncSetAttribute((const void*)hymba_mega<false, 4>, hipFuncAttributeMaxDynamicSharedMemorySize, LDS_BYTES);
        (void)hipFuncSetAttribute((const void*)hymba_mega<false, 5>, hipFuncAttributeMaxDynamicSharedMemorySize, LDS_BYTES);
        per_cu = 1;
#else
        (void)hipFuncSetAttribute((const void*)hymba_mega<true, 0>, hipFuncAttributeMaxDynamicSharedMemorySize, LDS_BYTES);
        (void)hipOccupancyMaxActiveBlocksPerMultiprocessor(&per_cu, hymba_mega<true, 0>, 512, LDS_BYTES);
#endif
        if (per_cu < 1) per_cu = 1;
        grid_blocks = cus * per_cu;
    }
#if MK_MULTI
    hipLaunchKernelGGL((hymba_mega<false, 0>), dim3(grid_blocks), dim3(512), LDS_BYTES, stream, p);
    hipLaunchKernelGGL((hymba_mega<false, 1>), dim3(grid_blocks), dim3(512), LDS_BYTES, stream, p);
    hipLaunchKernelGGL((hymba_mega<false, 2>), dim3(grid_blocks), dim3(512), LDS_BYTES, stream, p);
    hipLaunchKernelGGL((hymba_mega<false, 3>), dim3(grid_blocks), dim3(512), LDS_BYTES, stream, p);
    hipLaunchKernelGGL((hymba_mega<false, 4>), dim3(grid_blocks), dim3(512), LDS_BYTES, stream, p);
    hipLaunchKernelGGL((hymba_mega<false, 5>), dim3(grid_blocks), dim3(512), LDS_BYTES, stream, p);
#else
    p.phase_lo = 0; p.phase_hi = 5;
    void* args[] = {&p};
    hipError_t e = hipLaunchCooperativeKernel((const void*)hymba_mega<true, 0>, dim3(grid_blocks), dim3(512), args, LDS_BYTES, stream);
    if (e != hipSuccess) fprintf(stderr, "cooperative launch failed: %s (grid %d)\n", hipGetErrorString(e), grid_blocks);
#endif
}
```

```cpp
#include <hip/hip_runtime.h>
#include <hip/hip_cooperative_groups.h>
#include <cstdio>
#ifndef PROBE_DUP
#define PROBE_DUP 0
#endif
#ifndef MK_MULTI
#define MK_MULTI 0
#endif
namespace pg8 {
#define PG8_LAS __attribute__((address_space(3)))
typedef unsigned short bf16_t;
typedef short bf16x8 __attribute__((ext_vector_type(8)));
typedef float f32x4 __attribute__((ext_vector_type(4)));
typedef unsigned u32x4 __attribute__((ext_vector_type(4)));
constexpr int BM = 256, BK = 64, HALF = 128, HTB = HALF * BK * 2  , STAGE_BYTES = 8 * HTB, NXCD = 8, WGM = 8;

__host__ __device__ __forceinline__ int lds_byte(int r, int c) { const int st = (r >> 4) * 2 + (c >> 5), rr = r & 15, cc = c & 31, ob = rr * 64 + cc * 2; return st * 1024 + (ob ^ (((ob >> 9) & 1) << 5)); }
__host__ __device__ __forceinline__ void stage_rc(int b, int& R, int& C) { const int st = b / 1024, sb = b % 1024, swz = sb ^ (((sb >> 9) & 1) << 5); R = (st >> 1) * 16 + swz / 64; C = (st & 1) * 32 + (swz % 64) / 2; }
__host__ __device__ __forceinline__ int perm32(int rho) { const int n = rho >> 4, i = rho & 15; return 8 * (i >> 2) + 4 * n + (i & 3); }

struct Unit { int pm, pn, koff, klen; };
struct Gemm { const bf16_t* A; const bf16_t* Bt; int M, N, K; };

struct StaticOrder {
    int nM, nN, nwg, G, c;
    __host__ __device__ void init(int M, int N, int G_, int c_) { nM = M / BM; nN = N / BM; nwg = nM * nN; G = G_; c = c_; }
    __host__ __device__ bool next(int i, Unit& u) const {
        const long L = (long)i * G + c; if (L >= nwg) return false;
        int wgid = (int)L; { const int q = nwg / NXCD, r = nwg % NXCD, xcd = wgid % NXCD, off = wgid / NXCD; wgid = (xcd < r ? xcd * (q + 1) : r * (q + 1) + (xcd - r) * q) + off; }
        const int nig = WGM * nN, gid = wgid / nig, fm = gid * WGM, gsz = (nM - fm) < WGM ? (nM - fm) : WGM;
        u.pm = fm + ((wgid % nig) % gsz); u.pn = (wgid % nig) / gsz; u.koff = 0; u.klen = 0; return true;
    }
    __device__ __forceinline__ void a_ready(const Unit&) const {}
    __device__ __forceinline__ void done(const Unit&) const {}
};

template <class Epi, class Sched, bool STAMP = false>
__device__ __forceinline__ void gemm_phase(PG8_LAS unsigned char* lds, const Gemm g, const Sched& S, const Epi& E, unsigned long long* stamps) {
    int tid_ = threadIdx.x; asm volatile("" : "+v"(tid_)); const int tid = tid_, wid = __builtin_amdgcn_readfirstlane(tid >> 6), lane = tid & 63, wr = wid >> 2, wc = wid & 3, fr = lane & 15, fq = lane >> 4;
    const int K = g.K, nt = K / BK;
    int ts_lo = 0, ts_hi = 0, nts = 0; const unsigned long long rt_entry = STAMP ? (unsigned long long)wall_clock64() : 0ull;
#define PG8_STAMP() do { if (STAMP && wid == 0 && nts < 64) { const unsigned long long _c = (unsigned long long)clock64(); \
        ts_lo = (lane == nts) ? (int)(unsigned)_c : ts_lo; ts_hi = (lane == nts) ? (int)(unsigned)(_c >> 32) : ts_hi; ++nts; } } while (0)
    PG8_STAMP();
    unsigned voffA[2], voffB[2];
#pragma unroll
    for (int i = 0; i < 2; ++i) { int R, C; stage_rc(tid * 16 + i * 8192, R, C); const int Rb = Epi::PERM ? ((R & ~31) + perm32(R & 31)) : R;
        voffA[i] = (unsigned)(R * K + C) * 2u; voffB[i] = (unsigned)(Rb * K + C) * 2u; }
    const size_t kstep = (size_t)(BK * 2);
    const size_t hstep = (size_t)HALF * K * 2;
    const size_t tstep = 2 * hstep;
    const unsigned ldsw = (unsigned)wid * 1024u;
    const int aoff = lds_byte(wr * 64 + fr, fq * 8), boff = lds_byte(wc * 32 + fr, fq * 8);
#define PG8_SA(b, h) (((b) * 2 + (h)) * HTB)
#define PG8_SB(b, h) ((4 + (b) * 2 + (h)) * HTB)
#define PG8_STAGE(bufoff, gbase, voff) do { _Pragma("unroll") for (int _i = 0; _i < 2; ++_i) \
        __builtin_amdgcn_global_load_lds((const unsigned*)((const char*)(gbase) + (voff)[_i]), (PG8_LAS unsigned*)(lds + (bufoff) + ldsw + _i * 8192), 16, 0, 0); } while (0)
#define PG8_LDA(dst, b, h) do { _Pragma("unroll") for (int m = 0; m < 4; ++m) _Pragma("unroll") for (int k = 0; k < 2; ++k) dst[m][k] = *(const PG8_LAS bf16x8*)(lds + PG8_SA(b, h) + aoff + m * 2048 + k * 1024); } while (0)
#define PG8_LDB(dst, b, h) do { _Pragma("unroll") for (int n = 0; n < 2; ++n) _Pragma("unroll") for (int k = 0; k < 2; ++k) dst[n][k] = *(const PG8_LAS bf16x8*)(lds + PG8_SB(b, h) + boff + n * 2048 + k * 1024); } while (0)
#define PG8_MMA(ai, bj, At, Bt) do { __builtin_amdgcn_s_setprio(1); _Pragma("unroll") for (int m = 0; m < 4; ++m) _Pragma("unroll") for (int n = 0; n < 2; ++n) _Pragma("unroll") for (int k = 0; k < 2; ++k) \
        acc[ai][bj][m][n] = __builtin_amdgcn_mfma_f32_16x16x32_bf16(Bt[n][k], At[m][k], acc[ai][bj][m][n], 0, 0, 0); __builtin_amdgcn_s_setprio(0); } while (0)
#define PG8_WAIT_V(n) asm volatile("s_waitcnt vmcnt(" #n ")" ::: "memory")
#define PG8_WAIT_L(n) asm volatile("s_waitcnt lgkmcnt(" #n ")" ::: "memory")
#define PG8_BAR __builtin_amdgcn_s_barrier()
#define PG8_SCHED __builtin_amdgcn_sched_barrier(0)
    Unit cur, nxt; int ui = 0;
    if (!S.next(0, cur)) return;
    f32x4 acc[2][2][4][2];
#pragma unroll
    for (int a = 0; a < 2; ++a)
#pragma unroll
        for (int b = 0; b < 2; ++b)
#pragma unroll
            for (int m = 0; m < 4; ++m)
#pragma unroll
                for (int n = 0; n < 2; ++n) acc[a][b][m][n] = (f32x4){0.f, 0.f, 0.f, 0.f};
    bf16x8 At[4][2], B0[2][2], B1[2][2];
    const char* cA = (const char*)g.A + (size_t)cur.pm * tstep + (size_t)cur.koff * 2; const char* cB = (const char*)g.Bt + (size_t)cur.pn * tstep + (size_t)cur.koff * 2;
    S.a_ready(cur);
    PG8_STAGE(PG8_SB(0, 0), cB, voffB); PG8_STAGE(PG8_SA(0, 0), cA, voffA); PG8_STAGE(PG8_SB(0, 1), cB + hstep, voffB); PG8_STAGE(PG8_SA(0, 1), cA + hstep, voffA);
    if (wr == 1) PG8_BAR;
    PG8_WAIT_V(4); PG8_BAR;
    PG8_STAGE(PG8_SB(1, 0), cB + kstep, voffB); PG8_STAGE(PG8_SA(1, 0), cA + kstep, voffA); PG8_STAGE(PG8_SB(1, 1), cB + hstep + kstep, voffB);
    PG8_WAIT_V(6); PG8_BAR;
    PG8_STAMP();
    for (;;) {
        const bool has_next = S.next(ui + 1, nxt);
        const char* nA = has_next ? (const char*)g.A + (size_t)nxt.pm * tstep + (size_t)nxt.koff * 2 : cA; const char* nB = has_next ? (const char*)g.Bt + (size_t)nxt.pn * tstep + (size_t)nxt.koff * 2 : cB;
        const int ntc = cur.klen ? cur.klen / BK : nt;
        for (int t = 0; t < ntc; t += 2) {
            const bool last = (t == ntc - 2);
            const char* a1 = cA + (size_t)(t + 1) * kstep;
            const char* a2 = last ? nA : cA + (size_t)(t + 2) * kstep; const char* b2 = last ? nB : cB + (size_t)(t + 2) * kstep;
            const char* a3 = a2 + kstep; const char* b3 = b2 + kstep;
            if (last && has_next) S.a_ready(nxt);
            PG8_LDB(B0, 0, 0); PG8_SCHED; PG8_LDA(At, 0, 0); PG8_STAGE(PG8_SA(1, 1), a1 + hstep, voffA);
            PG8_WAIT_L(8); PG8_BAR; PG8_WAIT_L(0); PG8_MMA(0, 0, At, B0); PG8_BAR; PG8_SCHED;
            PG8_LDB(B1, 0, 1); PG8_STAGE(PG8_SB(0, 0), b2, voffB);
            PG8_BAR; PG8_WAIT_L(0); PG8_MMA(0, 1, At, B1); PG8_BAR;
            PG8_LDA(At, 0, 1); PG8_STAGE(PG8_SA(0, 0), a2, voffA);
            PG8_BAR; PG8_WAIT_L(0); PG8_MMA(1, 0, At, B0); PG8_BAR; PG8_SCHED;
            PG8_STAGE(PG8_SB(0, 1), b2 + hstep, voffB);
            PG8_WAIT_V(6); PG8_BAR; PG8_MMA(1, 1, At, B1); PG8_BAR;
            PG8_LDB(B0, 1, 0); PG8_SCHED; PG8_LDA(At, 1, 0); PG8_STAGE(PG8_SA(0, 1), a2 + hstep, voffA);
            PG8_WAIT_L(8); PG8_BAR; PG8_WAIT_L(0); PG8_MMA(0, 0, At, B0); PG8_BAR; PG8_SCHED;
            PG8_LDB(B1, 1, 1); PG8_STAGE(PG8_SB(1, 0), b3, voffB);
            PG8_BAR; PG8_WAIT_L(0); PG8_MMA(0, 1, At, B1); PG8_BAR;
            PG8_LDA(At, 1, 1); PG8_STAGE(PG8_SA(1, 0), a3, voffA);
            PG8_BAR; PG8_WAIT_L(0); PG8_MMA(1, 0, At, B0); PG8_BAR; PG8_SCHED;
            PG8_STAGE(PG8_SB(1, 1), b3 + hstep, voffB);
            PG8_WAIT_V(6); PG8_BAR; PG8_MMA(1, 1, At, B1); PG8_BAR;
        }
        PG8_STAMP();
        if constexpr (!Epi::AFTER_DRAIN) { E(acc, cur, wr, wc, fr, fq); S.done(cur); }
        PG8_STAMP();
        if (!has_next) break;
#pragma unroll
        for (int a = 0; a < 2; ++a)
#pragma unroll
            for (int b = 0; b < 2; ++b)
#pragma unroll
                for (int m = 0; m < 4; ++m)
#pragma unroll
                    for (int n = 0; n < 2; ++n) acc[a][b][m][n] = (f32x4){0.f, 0.f, 0.f, 0.f};
        cur = nxt; cA = nA; cB = nB; ++ui;
    }
    PG8_WAIT_V(0);
    if (wr == 0) PG8_BAR;
    PG8_BAR;
    if constexpr (Epi::AFTER_DRAIN) { E.fused(acc, cur, wr, wc, fr, fq, lds, wid, lane); S.done(cur); }
    PG8_STAMP();
    if (STAMP && wid == 0) { stamps[lane] = lane < nts ? (((unsigned long long)(unsigned)ts_hi << 32) | (unsigned)ts_lo) : 0ull;
        if (lane == 62) stamps[62] = rt_entry; if (lane == 63) stamps[63] = (unsigned long long)wall_clock64(); }
#undef PG8_STAMP
#undef PG8_SA
#undef PG8_SB
#undef PG8_STAGE
#undef PG8_LDA
#undef PG8_LDB
#undef PG8_MMA
#undef PG8_WAIT_V
#undef PG8_WAIT_L
#undef PG8_BAR
#undef PG8_SCHED
}
}
namespace cg = cooperative_groups;
using pg8::bf16_t; using pg8::bf16x8; using pg8::f32x4; using pg8::u32x4; using pg8::Unit;
#define LAS __attribute__((address_space(3)))
typedef short s16x4 __attribute__((ext_vector_type(4)));
typedef unsigned u32x2 __attribute__((ext_vector_type(2)));
typedef __bf16 bf2_t __attribute__((ext_vector_type(2)));
typedef float f2_t __attribute__((ext_vector_type(2)));
#define DI __device__ __forceinline__

constexpr int DM = 1024, SEQ = 2048, NMETA = 16, TPR = 2064, ROWS_P = 16512, ROWS_S = 1024, T = 17536, TP = 17664;
constexpr int DPROJ = 7176;
constexpr size_t O_YP = 0, O_YS = 16777216, O_PP = O_YS + 1048576, O_CP = O_PP + 122880, O_NP = O_CP + 2097152, O_MP = O_NP + 8192,
                 O_PS = O_MP + 32, O_CS = O_PS + 1966080, O_NS = O_CS + 33554432, O_MS = O_NS + 131072;
constexpr size_t SZ_ACT = (size_t)TP * 1024 * 2;
constexpr size_t W_XN = 0, W_WIN = W_XN + SZ_ACT, W_WOUT = W_WIN + (size_t)7168 * 1024 * 2, W_WPOOL = W_WOUT + (size_t)1024 * 2048 * 2,
                 W_GATES = W_WPOOL + 524288, W_U = W_GATES + (size_t)TP * 32, W_ZA = W_U + SZ_ACT, W_Q = W_ZA + SZ_ACT, W_K = W_Q + SZ_ACT,
                 W_V = W_K + SZ_ACT, W_G = W_V + SZ_ACT, W_HT = W_G + SZ_ACT, W_Y = W_HT + SZ_ACT, W_RSS = W_Y + 2 * SZ_ACT,
                 W_CTR = W_RSS + (size_t)TP * 64, W_BAR = W_CTR + 256, W_END = W_BAR + 16384;
constexpr int LDS_BYTES = 143872 + 16, L_XB = 143872;

struct Params {
    const float *x_prompt, *x_sample, *state_pool, *state_C, *state_n, *state_m, *meta, *norm1_w, *w_in, *b_if, *w_pool, *pool_scale, *mhln_w, *w_out, *normf_w;
    float* out;
    unsigned char* ws;
    int phase_lo, phase_hi;
};

DI int opaque_tid() { int t = threadIdx.x; asm volatile("" : "+v"(t)); return t; }
DI unsigned pk_bf16(float lo, float hi) { f2_t v = {lo, hi}; bf2_t r = __builtin_convertvector(v, bf2_t); return __builtin_bit_cast(unsigned, r); }
DI float bf_lo(unsigned u) { return __uint_as_float(u << 16); }
DI float bf_hi(unsigned u) { return __uint_as_float(u & 0xffff0000u); }
DI float bf2f(short s) { return __uint_as_float(((unsigned)(unsigned short)s) << 16); }
DI float wave_sum(float v) { for (int o = 32; o; o >>= 1) v += __shfl_xor(v, o); return v; }
DI float sigmoidf_(float x) { return __fdividef(1.f, 1.f + __expf(-x)); }
DI float siluf_(float x) { return x * sigmoidf_(x); }
DI f32x4 mfma16(bf16x8 a, bf16x8 b, f32x4 c) { return __builtin_amdgcn_mfma_f32_16x16x32_bf16(a, b, c, 0, 0, 0); }
DI s16x4 tr_read(const LAS unsigned char* a) { return __builtin_amdgcn_ds_read_tr16_b64_v4i16((LAS s16x4*)a); }
DI bf16x8 cat8(s16x4 lo, s16x4 hi) { return __builtin_shufflevector(lo, hi, 0, 1, 2, 3, 4, 5, 6, 7); }

#define XB_TMO      128
#define XB_XCNT(j)  (256  + 64 * (j))
#define XB_XSUB(j)  (1280 + 64 * (j))
#define XB_XGEN(j)  (2304 + 64 * (j))
#define XB_TOP      3328
#define XB_TOPGEN   3392
#define XCD_BAR_WORDS 3456
#define XB_SPIN_CAP (1u << 18)

__device__ __forceinline__ unsigned xb_ld(unsigned* p)              { return __hip_atomic_load(p, __ATOMIC_RELAXED, __HIP_MEMORY_SCOPE_AGENT); }
__device__ __forceinline__ unsigned xb_add(unsigned* p, unsigned v) { return __hip_atomic_fetch_add(p, v, __ATOMIC_RELAXED, __HIP_MEMORY_SCOPE_AGENT); }
__device__ __forceinline__ unsigned xb_xcc_id() { return (unsigned)__builtin_amdgcn_s_getreg((3 << 11) | 20) & 0xFu; }
#define XB_SPIN(cond, bar) do { unsigned _sp = 0; while (cond) { __builtin_amdgcn_s_sleep(1); \
    if ((++_sp & 255u) == 0u) { if (xb_ld(&(bar)[XB_TMO])) break; if (_sp > XB_SPIN_CAP) { atomicAdd(&(bar)[XB_TMO], 1u); break; } } } } while (0)

struct XcdBarrier {
    unsigned* bar; unsigned x;
    volatile LAS unsigned* st;
};

__device__ __forceinline__ XcdBarrier xcd_barrier_post(unsigned* bar, volatile LAS unsigned* st) {
    XcdBarrier b; b.bar = bar; b.x = xb_xcc_id(); b.st = st;
    if (threadIdx.x == 0) (void)xb_add(&bar[XB_XCNT(b.x)], 1u);
    return b;
}
__device__ __forceinline__ void xcd_barrier_complete(unsigned* bar, unsigned x, unsigned& nloc, unsigned& nx) {
    const unsigned G = gridDim.x * gridDim.y * gridDim.z;
    unsigned sum, cnt, mine, sp = 0u;
    for (;;) {
        sum = 0u; cnt = 0u; mine = 0u;
#pragma unroll
        for (unsigned j = 0; j < 16; ++j) { const unsigned c = xb_ld(&bar[XB_XCNT(j)]); sum += c; cnt += (c > 0u) ? 1u : 0u; mine = (j == x) ? c : mine; }
        if (sum == G) break;
        __builtin_amdgcn_s_sleep(1);
        if ((++sp & 255u) == 0u) { if (xb_ld(&bar[XB_TMO])) break; if (sp > XB_SPIN_CAP) { atomicAdd(&bar[XB_TMO], 1u); break; } }
    }
    nloc = mine > 0u ? mine : 1u; nx = cnt > 0u ? cnt : 1u;
}

__device__ __forceinline__ void xcd_barrier(const XcdBarrier& b) {
    asm volatile("s_waitcnt vmcnt(0)" ::: "memory");
    __syncthreads();
    if (threadIdx.x == 0) {
        unsigned* bar = b.bar;
        __builtin_amdgcn_s_waitcnt(0);
        unsigned nloc = b.st[0], nx = b.st[1];
        if (nloc == 0u) { xcd_barrier_complete(bar, b.x, nloc, nx); b.st[0] = nloc; b.st[1] = nx; }
        const unsigned old = xb_add(&bar[XB_XSUB(b.x)], 1u);
        const unsigned gen = old / nloc;
        if (old + 1u == (gen + 1u) * nloc) {
            __builtin_amdgcn_fence(__ATOMIC_RELEASE, "agent");
            asm volatile("s_waitcnt vmcnt(0)" ::: "memory");
            const unsigned og = xb_add(&bar[XB_TOP], 1u);
            const unsigned tg = og / nx;
            if (og + 1u == (tg + 1u) * nx) xb_add(&bar[XB_TOPGEN], 1u);
            else XB_SPIN(xb_ld(&bar[XB_TOPGEN]) == tg, bar);
            __builtin_amdgcn_fence(__ATOMIC_ACQUIRE, "agent");
            xb_add(&bar[XB_XGEN(b.x)], 1u);
            asm volatile("s_waitcnt vmcnt(0)" ::: "memory");
        } else {
            XB_SPIN(xb_ld(&bar[XB_XGEN(b.x)]) == gen, bar);
            __builtin_amdgcn_fence(__ATOMIC_ACQUIRE, "agent");
            asm volatile("s_waitcnt vmcnt(0)" ::: "memory");
        }
    }
    __syncthreads();
}


DI const float* row_src(const Params& p, int r) {
    if (r < ROWS_P) { const int b = r / TPR, t = r - b * TPR; return t < NMETA ? p.meta + (size_t)t * DM : p.x_prompt + ((size_t)(b * SEQ + t - NMETA)) * DM; }
    return p.x_sample + (size_t)(r - ROWS_P) * DM;
}

DI void p0_rows(const Params& p, int u, LAS unsigned char* lds, const float4 (&wa)[4][4], const float4 (&wb)[4][4]) {
    (void)lds;
    const int tid = opaque_tid(), lane = tid & 63, wid = __builtin_amdgcn_readfirstlane(tid >> 6);
    bf16_t* XN = (bf16_t*)(p.ws + W_XN); float* GATES = (float*)(p.ws + W_GATES);
    const int rbase = u * 32 + wid * 4;
    float4 x[4][4]; float ss[4];
#pragma unroll
    for (int q = 0; q < 4; ++q) {
        const int r = rbase + q; const float* src = row_src(p, r < T ? r : T - 1);
#pragma unroll
        for (int j = 0; j < 4; ++j) { const f32x4 t_ = __builtin_nontemporal_load((const f32x4*)(src + 4 * lane + 256 * j)); x[q][j].x = t_[0]; x[q][j].y = t_[1]; x[q][j].z = t_[2]; x[q][j].w = t_[3]; }
    }
#pragma unroll
    for (int q = 0; q < 4; ++q) { float a = 0.f;
#pragma unroll
        for (int j = 0; j < 4; ++j) a += x[q][j].x * x[q][j].x + x[q][j].y * x[q][j].y + x[q][j].z * x[q][j].z + x[q][j].w * x[q][j].w;
        ss[q] = a; }
#pragma unroll
    for (int o = 32; o; o >>= 1) {
#pragma unroll
        for (int q = 0; q < 4; ++q) ss[q] += __shfl_xor(ss[q], o); }
#pragma unroll
    for (int q = 0; q < 4; ++q) {
        const int r = rbase + q;
        if (r >= T) { const u32x4 z = {0u, 0u, 0u, 0u}; *(u32x4*)(XN + (size_t)r * 1024 + lane * 16) = z; *(u32x4*)(XN + (size_t)r * 1024 + lane * 16 + 8) = z; continue; }
        const float rstd = rsqrtf(ss[q] * (1.f / 1024.f) + 1e-6f);
        float ga[8];
#pragma unroll
        for (int g = 0; g < 8; ++g) ga[g] = 0.f;
#pragma unroll
        for (int j = 0; j < 4; ++j) {
            const float4 nw = *(const float4*)(p.norm1_w + 4 * lane + 256 * j);
            float y[4]; y[0] = x[q][j].x * rstd * nw.x; y[1] = x[q][j].y * rstd * nw.y; y[2] = x[q][j].z * rstd * nw.z; y[3] = x[q][j].w * rstd * nw.w;
            u32x2 o; o.x = pk_bf16(y[0], y[1]); o.y = pk_bf16(y[2], y[3]);
            *(u32x2*)(XN + (size_t)r * 1024 + 4 * lane + 256 * j) = o;
#pragma unroll
            for (int e = 0; e < 4; ++e) { ga[0] += y[e] * wa[j][e].x; ga[1] += y[e] * wa[j][e].y; ga[2] += y[e] * wa[j][e].z; ga[3] += y[e] * wa[j][e].w;
                                          ga[4] += y[e] * wb[j][e].x; ga[5] += y[e] * wb[j][e].y; ga[6] += y[e] * wb[j][e].z; ga[7] += y[e] * wb[j][e].w; }
        }
        float h4[4], h2[2], h1;
        { const bool up = lane & 32;
#pragma unroll
          for (int g = 0; g < 4; ++g) { const float keep = up ? ga[4 + g] : ga[g], give = up ? ga[g] : ga[4 + g]; h4[g] = keep + __shfl_xor(give, 32); } }
        { const bool up = lane & 16;
#pragma unroll
          for (int g = 0; g < 2; ++g) { const float keep = up ? h4[2 + g] : h4[g], give = up ? h4[g] : h4[2 + g]; h2[g] = keep + __shfl_xor(give, 16); } }
        { const bool up = lane & 8; const float keep = up ? h2[1] : h2[0], give = up ? h2[0] : h2[1]; h1 = keep + __shfl_xor(give, 8); }
        h1 += __shfl_xor(h1, 4); h1 += __shfl_xor(h1, 2); h1 += __shfl_xor(h1, 1);
        if ((lane & 7) == 0) {
            const int g = ((lane >> 5) & 1) * 4 + ((lane >> 4) & 1) * 2 + ((lane >> 3) & 1);
            const float v = h1 + p.b_if[g];
            GATES[(size_t)r * 8 + g] = g < 4 ? v : fminf(v, 0.f) - log1pf(__expf(-fabsf(v)));
        }
    }
}

DI void p0_transpose(const float* src, int src_pitch, int cb0, int cb1, bool perm, float scale, bf16_t* dst, int dst_pitch, int k0, LAS unsigned char* lds) {
    LAS float* tile = (LAS float*)lds;
    const int tid = opaque_tid();
    const int c4 = (tid & 63) * 4, r0 = tid >> 6;
    const int scol = c4 < 128 ? cb0 + c4 : cb1 + c4 - 128;
#pragma unroll
    for (int i = 0; i < 8; ++i) { const int row = r0 + 8 * i; const f32x4 v = __builtin_nontemporal_load((const f32x4*)(src + (size_t)(k0 + row) * src_pitch + scol));
        tile[row * 257 + c4 + 0] = v[0]; tile[row * 257 + c4 + 1] = v[1]; tile[row * 257 + c4 + 2] = v[2]; tile[row * 257 + c4 + 3] = v[3]; }
    __syncthreads();
    const int kg = tid & 7;
#pragma unroll
    for (int i = 0; i < 4; ++i) {
        const int r = (tid >> 3) + 64 * i;
        const int c = perm ? ((r & ~31) + pg8::perm32(r & 31)) : r;
        float v[8];
#pragma unroll
        for (int j = 0; j < 8; ++j) v[j] = tile[(kg * 8 + j) * 257 + c] * scale;
        u32x4 o; o.x = pk_bf16(v[0], v[1]); o.y = pk_bf16(v[2], v[3]); o.z = pk_bf16(v[4], v[5]); o.w = pk_bf16(v[6], v[7]);
        *(u32x4*)(dst + (size_t)r * dst_pitch + k0 + kg * 8) = o;
    }
    __syncthreads();
}

constexpr int NU0_ROWS = TP / 32  , NU0_WIN = 28 * 16, NU0_WOUT = 4 * 32, NU0_WPOOL = 4 * 4, NU0 = NU0_ROWS + NU0_WIN + NU0_WPOOL;
DI void phase0(const Params& p, LAS unsigned char* lds) {
    if (blockIdx.x == 0 && threadIdx.x < 8) ((unsigned*)(p.ws + W_CTR))[threadIdx.x] = 0u;
    float4 wa[4][4], wb[4][4];
    {   LAS float* Wg = (LAS float*)lds;
        for (int k = threadIdx.x; k < 1024; k += 512) { const float* wp = p.w_in + (size_t)k * DPROJ + 7168;
            const f32x4 a = __builtin_nontemporal_load((const f32x4*)wp), b = __builtin_nontemporal_load((const f32x4*)(wp + 4));
            *(LAS f32x4*)(Wg + k * 8) = a; *(LAS f32x4*)(Wg + k * 8 + 4) = b; }
        __syncthreads();
        const int lane_ = threadIdx.x & 63;
#pragma unroll
        for (int j = 0; j < 4; ++j)
#pragma unroll
            for (int e = 0; e < 4; ++e) { const int k = 4 * lane_ + 256 * j + e; const f32x4 a = *(const LAS f32x4*)(Wg + k * 8), b = *(const LAS f32x4*)(Wg + k * 8 + 4);
                wa[j][e].x = a[0]; wa[j][e].y = a[1]; wa[j][e].z = a[2]; wa[j][e].w = a[3]; wb[j][e].x = b[0]; wb[j][e].y = b[1]; wb[j][e].z = b[2]; wb[j][e].w = b[3]; }
        __syncthreads();
    }
    for (int u = blockIdx.x; u < NU0; u += gridDim.x) {
        if (u < NU0_ROWS) p0_rows(p, u, lds, wa, wb);
        else if (u < NU0_ROWS + NU0_WIN) { const int i = u - NU0_ROWS, pn = i >> 4, kb = i & 15;
            const int cb0 = pn < 20 ? 256 * pn : 5120 + 128 * (pn - 20), cb1 = pn < 20 ? 256 * pn + 128 : 6144 + 128 * (pn - 20);
            p0_transpose(p.w_in, DPROJ, cb0, cb1, true, (pn >= 12 && pn < 16) ? 0.0625f : 1.f, (bf16_t*)(p.ws + W_WIN) + (size_t)pn * 256 * 1024, 1024, 64 * kb, lds); }
        else { const int i = u - NU0_ROWS - NU0_WIN, g = i >> 2, kb = i & 3;
            p0_transpose(p.w_pool + (size_t)g * 65536, 256, 0, 128, false, 1.f, (bf16_t*)(p.ws + W_WPOOL) + (size_t)g * 65536, 256, 64 * kb, lds); }
    }
}


struct SegOrder {
    int G, c, first, last;
    __device__ __forceinline__ static void map(int l, int nN, Unit& u) {
        const int nM = 69, nwg = nM * nN; int wgid = l;
        { const int q = nwg / 8, r = nwg % 8, xcd = wgid % 8, off = wgid / 8; wgid = (xcd < r ? xcd * (q + 1) : r * (q + 1) + (xcd - r) * q) + off; }
        const int nig = 8 * nN, gid = wgid / nig, fm = gid * 8, gsz = (nM - fm) < 8 ? (nM - fm) : 8;
        u.pm = fm + ((wgid % nig) % gsz); u.pn = (wgid % nig) / gsz; u.koff = 0; u.klen = 0;
    }
    __device__ __forceinline__ bool next(int i, Unit& u) const {
        const int L = first + i * G + c; if (L >= last) return false;
        if (L < 1380) map(L, 20, u); else { map(L - 1380, 8, u); u.pn += 20; }
        return true;
    }
    __device__ __forceinline__ void a_ready(const Unit&) const {}
    __device__ __forceinline__ void done(const Unit&) const {}
};
struct EpiG1 {
    static constexpr bool PERM = false, AFTER_DRAIN = false;
    bf16_t *U, *ZA, *Q, *K, *V, *G; const float* pool_scale;
    DI void operator()(const f32x4 (&acc)[2][2][4][2], const Unit& u, int wr, int wc, int fr, int fq) const {
        const int row0 = u.pm * 256 + wr * 64 + fr, cl = wc * 32 + 8 * fq;
        if (u.pn >= 20) {
            const int col = (u.pn - 20) * 128 + cl;
#pragma unroll
            for (int ai = 0; ai < 2; ++ai)
#pragma unroll
                for (int m = 0; m < 4; ++m) {
                    const int row = row0 + ai * 128 + m * 16;
                    float r[8];
#pragma unroll
                    for (int i = 0; i < 4; ++i) { r[i] = sigmoidf_(acc[ai][0][m][0][i]) * siluf_(acc[ai][1][m][0][i]); r[4 + i] = sigmoidf_(acc[ai][0][m][1][i]) * siluf_(acc[ai][1][m][1][i]); }
                    u32x4 o; o.x = pk_bf16(r[0], r[1]); o.y = pk_bf16(r[2], r[3]); o.z = pk_bf16(r[4], r[5]); o.w = pk_bf16(r[6], r[7]);
                    *(u32x4*)(G + (size_t)row * 1024 + col) = o;
                }
        } else {
            const int tsel = u.pn >> 2;
            bf16_t* base = tsel == 0 ? U : tsel == 1 ? ZA : tsel == 2 ? Q : tsel == 3 ? K : V;
#pragma unroll
            for (int bj = 0; bj < 2; ++bj) {
                const int col = (u.pn & 3) * 256 + bj * 128 + cl;
                float ps[8];
                if (tsel == 1) { const float4 a = *(const float4*)(pool_scale + col), b = *(const float4*)(pool_scale + col + 4); ps[0] = a.x; ps[1] = a.y; ps[2] = a.z; ps[3] = a.w; ps[4] = b.x; ps[5] = b.y; ps[6] = b.z; ps[7] = b.w; }
#pragma unroll
                for (int ai = 0; ai < 2; ++ai)
#pragma unroll
                    for (int m = 0; m < 4; ++m) {
                        const int row = row0 + ai * 128 + m * 16;
                        float r[8];
#pragma unroll
                        for (int i = 0; i < 4; ++i) { r[i] = acc[ai][bj][m][0][i]; r[4 + i] = acc[ai][bj][m][1][i]; }
                        if (tsel == 1) {
#pragma unroll
                            for (int i = 0; i < 8; ++i) r[i] = siluf_(r[i]) * ps[i];
                        }
                        u32x4 o; o.x = pk_bf16(r[0], r[1]); o.y = pk_bf16(r[2], r[3]); o.z = pk_bf16(r[4], r[5]); o.w = pk_bf16(r[6], r[7]);
                        *(u32x4*)(base + (size_t)row * 1024 + col) = o;
                    }
            }
        }
    }
};

struct G2Order {
    int G, c;
    __device__ __forceinline__ bool next(int i, Unit& u) const {
        const int L = i * G + c;
        if (L < 256) { u.pm = L >> 2; u.pn = L & 3; u.koff = 0; u.klen = 0; return true; }
        const int idx = L - 256; if (idx >= 160) return false;
        const int tile = idx >> 3; u.pm = 64 + (tile >> 2); u.pn = tile & 3; u.koff = (idx & 7) * 256; u.klen = 256; return true;
    }
    __device__ __forceinline__ void a_ready(const Unit&) const {}
    __device__ __forceinline__ void done(const Unit&) const {}
};
struct EpiG2 {
    static constexpr bool PERM = false, AFTER_DRAIN = false;
    const float* x_prompt; long xs_delta; float* out; float* part; float* rss; unsigned* pcnt; const float* normf_w;
    DI void operator()(const f32x4 (&acc)[2][2][4][2], const Unit& u, int wr, int wc, int fr, int fq) const {
        const int row0 = u.pm * 256 + wr * 64 + fr, col0 = u.pn * 256 + wc * 32 + 4 * fq;
        if (u.klen != 0) {
#pragma unroll
            for (int ai = 0; ai < 2; ++ai)
#pragma unroll
                for (int m = 0; m < 4; ++m) {
                    const int row = row0 + ai * 128 + m * 16;
                    if (row < T) { float* pp = part + ((size_t)(u.koff >> 8) * 1280 + (row - 16384)) * 1024;
#pragma unroll
                        for (int bj = 0; bj < 2; ++bj)
#pragma unroll
                            for (int n = 0; n < 2; ++n) { const int c = col0 + bj * 128 + n * 16; *(f32x4*)(pp + c) = acc[ai][bj][m][n]; } }
                }
            return;
        }
        f32x4 (&va)[2][2][4][2] = const_cast<f32x4 (&)[2][2][4][2]>(acc);
#pragma unroll
        for (int ai = 0; ai < 2; ++ai)
#pragma unroll
            for (int m = 0; m < 4; ++m) {
                const int row = row0 + ai * 128 + m * 16;
                const int b = row / TPR, t = row - b * TPR; const bool valid = t >= NMETA;
                const float* xin = x_prompt + ((long)(b * SEQ + t - NMETA)) * 1024;
                float ss = 0.f;
                if (valid) {
#pragma unroll
                    for (int bj = 0; bj < 2; ++bj)
#pragma unroll
                        for (int n = 0; n < 2; ++n) { const int c = col0 + bj * 128 + n * 16; const f32x4 v = va[ai][bj][m][n] + __builtin_nontemporal_load((const f32x4*)(xin + c)); va[ai][bj][m][n] = v; ss += v[0] * v[0] + v[1] * v[1] + v[2] * v[2] + v[3] * v[3]; }
                }
                ss += __shfl_xor(ss, 16); ss += __shfl_xor(ss, 32);
                if (valid && fq == 0) (void)__hip_atomic_fetch_add(rss + row, ss, __ATOMIC_RELAXED, __HIP_MEMORY_SCOPE_AGENT);
            }
        unsigned* cnt = pcnt + (u.pm * 2 + wr) * 4;
        asm volatile("s_waitcnt vmcnt(0)" ::: "memory");
        if ((threadIdx.x & 63) == 0) (void)__hip_atomic_fetch_add(cnt, 1u, __ATOMIC_RELAXED, __HIP_MEMORY_SCOPE_AGENT);
        for (unsigned sp = 0; sp < (1u << 22); ++sp) {
            const unsigned seen = (unsigned)__builtin_amdgcn_readfirstlane((int)__hip_atomic_load(cnt, __ATOMIC_RELAXED, __HIP_MEMORY_SCOPE_AGENT));
            if (seen >= 16u) break;
            __builtin_amdgcn_s_sleep(1);
        }
        asm volatile("" ::: "memory");
        f32x4 nw[2][2];
#pragma unroll
        for (int bj = 0; bj < 2; ++bj)
#pragma unroll
            for (int n = 0; n < 2; ++n) nw[bj][n] = *(const f32x4*)(normf_w + col0 + bj * 128 + n * 16);
#pragma unroll
        for (int ai = 0; ai < 2; ++ai)
#pragma unroll
            for (int m = 0; m < 4; ++m) {
                const int row = row0 + ai * 128 + m * 16;
                const int b = row / TPR, t = row - b * TPR; const bool valid = t >= NMETA;
                const long off = ((long)(b * SEQ + t - NMETA)) * 1024;
                if (valid) {
                    const float tot = __hip_atomic_load(rss + row, __ATOMIC_RELAXED, __HIP_MEMORY_SCOPE_AGENT);
                    const float rstd = rsqrtf(tot * (1.f / 1024.f) + 1e-6f);
#pragma unroll
                    for (int bj = 0; bj < 2; ++bj)
#pragma unroll
                        for (int n = 0; n < 2; ++n) { const int c = col0 + bj * 128 + n * 16;
                            __builtin_nontemporal_store(va[ai][bj][m][n] * rstd * nw[bj][n], (f32x4*)(out + off + c)); }
                }
            }
    }
};

constexpr int L_Q = 0, L_K = 33792, L_V = 68608, L_SW = 87040, L_AL = 96256, L_GG = 104704, L_MM = 113152, L_MP = 121600, L_NV = 121856,
              L_QD = 122880, L_DEN = 123136, L_WE = 123392, L_BL = 123648, L_PL = 123904, L_CTL = 124160, L_NB = 124416, L_NZ = 124928, L_OUT = 125440;
constexpr int QST = 528, KST = 544, VST = 288, SST = 144;

DI void lds_bar() { asm volatile("s_waitcnt lgkmcnt(0)" ::: "memory"); __builtin_amdgcn_s_barrier(); asm volatile("" ::: "memory"); }

DI void scan_unit(const Params& p, const int b, const int h, const int eh, LAS unsigned char* lds) {
    const int tid = opaque_tid(), lane = tid & 63, wid = __builtin_amdgcn_readfirstlane(tid >> 6), fr = lane & 15, fq = lane >> 4;
    constexpr int nch = 33;
    const int rowbase = b * TPR;
    const int ecol = h * 256 + eh * 128, e0 = 16 * wid;
    LAS float* AL = (LAS float*)(lds + L_AL); LAS float* GG = (LAS float*)(lds + L_GG); LAS float* MM = (LAS float*)(lds + L_MM); LAS float* MP = (LAS float*)(lds + L_MP);
    LAS float* NV = (LAS float*)(lds + L_NV); LAS float* QD = (LAS float*)(lds + L_QD); LAS float* DEN = (LAS float*)(lds + L_DEN);
    LAS float* BL = (LAS float*)(lds + L_BL); LAS float* PL = (LAS float*)(lds + L_PL);
    const float* GATES = (const float*)(p.ws + W_GATES);
    const bf16_t* Qg = (const bf16_t*)(p.ws + W_Q); const bf16_t* Kg = (const bf16_t*)(p.ws + W_K); const bf16_t* Vg = (const bf16_t*)(p.ws + W_V);
    bf16_t* HT = (bf16_t*)(p.ws + W_HT);
    constexpr int npos = nch * 64;
    const int ldr = tid >> 3, ldseg = tid & 7;
    u32x4 pq[4], pk[4], pv[2];
    const u32x4 z4 = {0u, 0u, 0u, 0u};
#define SCAN_ISSUE(cc) do { const int L_ = (cc) == 0 ? 16 : 64, t0_ = (cc) == 0 ? 0 : 16 + 64 * ((cc) - 1); const size_t grow_ = (size_t)(rowbase + t0_ + ldr) * 1024; \
        _Pragma("unroll") for (int i_ = 0; i_ < 4; ++i_) { pq[i_] = z4; pk[i_] = z4; if (ldr < L_) { pq[i_] = *(const u32x4*)(Qg + grow_ + h * 256 + (ldseg + 8 * i_) * 8); pk[i_] = *(const u32x4*)(Kg + grow_ + h * 256 + (ldseg + 8 * i_) * 8); } } \
        _Pragma("unroll") for (int i_ = 0; i_ < 2; ++i_) { pv[i_] = z4; if (ldr < L_) pv[i_] = *(const u32x4*)(Vg + grow_ + ecol + (ldseg + 8 * i_) * 8); } } while (0)
    SCAN_ISSUE(0);
    __syncthreads();
    for (int idx = tid; idx < npos; idx += 512) {
        const int c = idx >> 6, i = idx & 63;
        const int L = c == 0 ? 16 : 64;
        const int t = c == 0 ? i : 16 + 64 * (c - 1) + i;
        float lf = 0.f, ig = -INFINITY;
        if (i < L) { const float* g = GATES + (size_t)(rowbase + t) * 8; ig = g[h]; lf = g[4 + h]; }
        AL[idx] = lf; GG[idx] = ig;
    }
    if (tid < 256) { NV[tid] = 0.f; *(LAS unsigned*)(lds + L_NB + tid * 4) = 0u; }
    __syncthreads();
    if (tid < nch) {
        const int c = tid; const int L = c == 0 ? 16 : 64;
        float bs = 0.f, P = -INFINITY;
        for (int i = 0; i < L; ++i) { const int idx = c * 64 + i; bs += AL[idx]; const float g = GG[idx] - bs; P = fmaxf(P, g); AL[idx] = bs; GG[idx] = g; MM[idx] = P; }
        BL[c] = bs; PL[c] = P;
    }
    __syncthreads();
    if (tid == 0) { float m = 0.f; MP[0] = m; for (int c = 0; c < nch; ++c) { m = BL[c] + fmaxf(m, PL[c]); MP[c + 1] = m; } }
    __syncthreads();
    for (int idx = tid; idx < npos; idx += 512) {
        const int c = idx >> 6, i = idx & 63;
        const int L = c == 0 ? 16 : 64;
        if (i < L) { const float bt = AL[idx]; const float mt = bt + fmaxf(MP[c], MM[idx]); AL[idx] = bt - mt; MM[idx] = mt; }
        else { AL[idx] = 0.f; MM[idx] = 0.f; }
    }
    f32x4 C[16];
#pragma unroll
    for (int i = 0; i < 16; ++i) C[i] = (f32x4){0.f, 0.f, 0.f, 0.f};
    __syncthreads();
#define SCAN_OUT(cc) do { const int L_ = (cc) == 0 ? 16 : 64, t0_ = (cc) == 0 ? 0 : 16 + 64 * ((cc) - 1); const float dn_ = DEN[ldr]; \
        _Pragma("unroll") for (int i_ = 0; i_ < 2; ++i_) { const u32x4 v_ = *(const LAS u32x4*)(lds + L_OUT + ldr * VST + (ldseg + 8 * i_) * 16); u32x4 o_; \
            o_.x = pk_bf16(bf_lo(v_.x) * dn_, bf_hi(v_.x) * dn_); o_.y = pk_bf16(bf_lo(v_.y) * dn_, bf_hi(v_.y) * dn_); o_.z = pk_bf16(bf_lo(v_.z) * dn_, bf_hi(v_.z) * dn_); o_.w = pk_bf16(bf_lo(v_.w) * dn_, bf_hi(v_.w) * dn_); \
            if (ldr < L_) *(u32x4*)(HT + (size_t)(rowbase + t0_ + ldr) * 1024 + ecol + (ldseg + 8 * i_) * 8) = o_; } } while (0)
    for (int c = 0; c < nch; ++c) {
        const int L = c == 0 ? 16 : 64;
        const int gi = c * 64;
#pragma unroll
        for (int i = 0; i < 4; ++i) {
            const int c16 = ldseg + 8 * i, blk = c16 >> 2, g4 = (c16 & 3) * 2;
            const int s0 = 2 * (g4 & 3) + (g4 >> 2), s1 = 2 * ((g4 + 1) & 3) + ((g4 + 1) >> 2);
            u32x2 qa_, qb_; qa_.x = pq[i].x; qa_.y = pq[i].y; qb_.x = pq[i].z; qb_.y = pq[i].w;
            *(LAS u32x2*)(lds + L_Q + ldr * QST + blk * 64 + s0 * 8) = qa_; *(LAS u32x2*)(lds + L_Q + ldr * QST + blk * 64 + s1 * 8) = qb_;
            *(LAS u32x4*)(lds + L_K + ldr * KST + c16 * 16) = pk[i]; }
#pragma unroll
        for (int i = 0; i < 2; ++i) *(LAS u32x4*)(lds + L_V + ldr * VST + (ldseg + 8 * i) * 16) = pv[i];
        if (c + 1 < nch) SCAN_ISSUE(c + 1);
        lds_bar();
#define SB() __builtin_amdgcn_sched_barrier(0)
        {
            const int tt = wid >> 1;
            bf16x8 bq[8];
#pragma unroll
            for (int kk = 0; kk < 8; ++kk) { const LAS unsigned char* qp = lds + L_Q + (16 * tt + fr) * QST + kk * 64 + ((((fq & 1) << 2) | (fq >> 1)) * 8);
                bq[kk] = cat8(*(const LAS s16x4*)qp, *(const LAS s16x4*)(qp + 16)); }
#pragma unroll
            for (int si = 0; si < 2; ++si) {
                const int st = 2 * (wid & 1) + si;
                u32x2 outv = {0u, 0u};
                if (st <= tt) {
                    bf16x8 ak[8];
#pragma unroll
                    for (int kk = 0; kk < 8; ++kk) ak[kk] = *(const LAS bf16x8*)(lds + L_K + (16 * st + fr) * KST + (kk * 32 + fq * 8) * 2);
                    const int t = 16 * tt + fr; const float al = AL[gi + t];
                    const f32x4 g4 = *(const LAS f32x4*)(GG + gi + 16 * st + 4 * fq);
                    SB();
                    f32x4 a = {0.f, 0.f, 0.f, 0.f}, a2 = {0.f, 0.f, 0.f, 0.f};
#pragma unroll
                    for (int kk = 0; kk < 8; kk += 2) { a = mfma16(ak[kk], bq[kk], a); a2 = mfma16(ak[kk + 1], bq[kk + 1], a2); }
                    a += a2;
                    float w[4];
#pragma unroll
                    for (int j = 0; j < 4; ++j) { const int sx = 16 * st + 4 * fq + j; w[j] = (sx <= t) ? a[j] * __expf(al + g4[j]) : 0.f; }
                    outv.x = pk_bf16(w[0], w[1]); outv.y = pk_bf16(w[2], w[3]);
                }
                *(LAS u32x2*)(lds + L_SW + (16 * tt + fr) * SST + (16 * st + 4 * fq) * 2) = outv;
                SB();
            }
        }
        f32x4 num[4];
#pragma unroll
        for (int mt = 0; mt < 4; ++mt) num[mt] = (f32x4){0.f, 0.f, 0.f, 0.f};
        {
            bf16x8 qf[2][4], nf[2], pf[2]; f32x4 qacc = {0.f, 0.f, 0.f, 0.f};
            const bool qdw = wid < 4;
            const LAS unsigned char* nbp = lds + (fr == 0 ? L_NB : L_NZ) + (8 * fq) * 2;
            const LAS unsigned char* qdp = lds + L_Q + (16 * (wid & 3) + fr) * QST + (8 * fq) * 2;
#define QLOAD(buf, k_) do { _Pragma("unroll") for (int mt = 0; mt < 4; ++mt) qf[buf][mt] = *(const LAS bf16x8*)(lds + L_Q + (16 * mt + fr) * QST + (32 * (k_) + 8 * fq) * 2); \
                if (qdw) { nf[buf] = *(const LAS bf16x8*)(nbp + (k_) * 64); pf[buf] = *(const LAS bf16x8*)(qdp + (k_) * 64); } } while (0)
            QLOAD(0, 0);
#pragma unroll
            for (int kk = 0; kk < 8; ++kk) {
                if (kk < 7) QLOAD((kk + 1) & 1, kk + 1);
                u32x4 bc; bc.x = pk_bf16(C[2 * kk][0], C[2 * kk][1]); bc.y = pk_bf16(C[2 * kk][2], C[2 * kk][3]); bc.z = pk_bf16(C[2 * kk + 1][0], C[2 * kk + 1][1]); bc.w = pk_bf16(C[2 * kk + 1][2], C[2 * kk + 1][3]);
                const bf16x8 cfrag = __builtin_bit_cast(bf16x8, bc);
                SB();
#pragma unroll
                for (int mt = 0; mt < 4; ++mt) num[mt] = mfma16(cfrag, qf[kk & 1][mt], num[mt]);
                if (qdw) qacc = mfma16(nf[kk & 1], pf[kk & 1], qacc);
                SB();
            }
#undef QLOAD
            if (qdw && fq == 0) QD[16 * wid + fr] = qacc[0];
        }
        if (c > 0) SCAN_OUT(c - 1);
        lds_bar();
        const float mprev = MP[c];
        const float alast = AL[gi + L - 1];
        const float decay = __expf(alast + mprev);
        bf16x8 vb[2], vw[2], wn[2], swa[6];
        {
            s16x4 v0[2], v1[2]; f32x4 g0[2], g1[2]; float sc[4];
#pragma unroll
            for (int kk = 0; kk < 2; ++kk) {
                const LAS unsigned char* base = lds + L_V + (32 * kk + 4 * fq + (fr >> 2)) * VST + (e0 + 4 * (fr & 3)) * 2;
                v0[kk] = tr_read(base); v1[kk] = tr_read(base + 16 * VST);
                g0[kk] = *(const LAS f32x4*)(GG + gi + 32 * kk + 4 * fq); g1[kk] = *(const LAS f32x4*)(GG + gi + 32 * kk + 16 + 4 * fq);
            }
#pragma unroll
            for (int mt = 0; mt < 4; ++mt) sc[mt] = AL[gi + 16 * mt + fr];
#define SWF(row, k0) cat8(*(const LAS s16x4*)(lds + L_SW + ((row) + fr) * SST + ((k0) + 4 * fq) * 2), *(const LAS s16x4*)(lds + L_SW + ((row) + fr) * SST + ((k0) + 16 + 4 * fq) * 2))
            swa[0] = SWF(0, 0); swa[1] = SWF(16, 0); swa[2] = SWF(32, 0); swa[3] = SWF(32, 32); swa[4] = SWF(48, 0); swa[5] = SWF(48, 32);
#undef SWF
            SB();
#pragma unroll
            for (int mt = 0; mt < 4; ++mt) { const float e = __expf(sc[mt] + mprev);
#pragma unroll
                for (int j = 0; j < 4; ++j) num[mt][j] *= e; }
#pragma unroll
            for (int kk = 0; kk < 2; ++kk) {
                vb[kk] = cat8(v0[kk], v1[kk]);
                float f[8], we[8];
#pragma unroll
                for (int j = 0; j < 4; ++j) { we[j] = __expf(alast + g0[kk][j]); we[4 + j] = __expf(alast + g1[kk][j]); f[j] = bf2f(vb[kk][j]) * we[j]; f[4 + j] = bf2f(vb[kk][4 + j]) * we[4 + j]; }
                u32x4 o; o.x = pk_bf16(f[0], f[1]); o.y = pk_bf16(f[2], f[3]); o.z = pk_bf16(f[4], f[5]); o.w = pk_bf16(f[6], f[7]);
                vw[kk] = __builtin_bit_cast(bf16x8, o);
                u32x4 wo; wo.x = pk_bf16(we[0], we[1]); wo.y = pk_bf16(we[2], we[3]); wo.z = pk_bf16(we[4], we[5]); wo.w = pk_bf16(we[6], we[7]);
                if (fr != 0) { wo.x = 0u; wo.y = 0u; wo.z = 0u; wo.w = 0u; }
                wn[kk] = __builtin_bit_cast(bf16x8, wo);
            }
        }
        {
            const int t = wid * 8 + (lane >> 3), part = lane & 7;
            const bf16x8 v = *(const LAS bf16x8*)(lds + L_SW + t * SST + part * 16);
            float rs = 0.f;
#pragma unroll
            for (int j = 0; j < 8; ++j) rs += bf2f(v[j]);
            rs += __shfl_xor(rs, 1); rs += __shfl_xor(rs, 2); rs += __shfl_xor(rs, 4);
            if (part == 0) { const float inter = __expf(AL[gi + t] + mprev);
                DEN[t] = __fdividef(1.f, fmaxf(fabsf(inter * QD[t] + rs), __expf(-MM[gi + t]))); }
        }
        num[0] = mfma16(vb[0], swa[0], num[0]); num[1] = mfma16(vb[0], swa[1], num[1]);
        num[2] = mfma16(vb[0], swa[2], num[2]); num[2] = mfma16(vb[1], swa[3], num[2]);
        num[3] = mfma16(vb[0], swa[4], num[3]); num[3] = mfma16(vb[1], swa[5], num[3]);
#pragma unroll
        for (int mt = 0; mt < 4; ++mt) { u32x2 o; o.x = pk_bf16(num[mt][0], num[mt][1]); o.y = pk_bf16(num[mt][2], num[mt][3]);
            *(LAS u32x2*)(lds + L_OUT + (16 * mt + fr) * VST + (e0 + 4 * fq) * 2) = o; }
        {
            s16x4 ka[2][8];
            const LAS unsigned char* kb0 = lds + L_K + (4 * fq + (fr >> 2)) * KST + (4 * (fr & 3)) * 2;
#define KLOAD(buf, ii) do { _Pragma("unroll") for (int h_ = 0; h_ < 2; ++h_) { ka[buf][4 * h_ + 0] = tr_read(kb0 + ((ii) + h_) * 32); ka[buf][4 * h_ + 1] = tr_read(kb0 + ((ii) + h_) * 32 + 16 * KST); \
                ka[buf][4 * h_ + 2] = tr_read(kb0 + ((ii) + h_) * 32 + 32 * KST); ka[buf][4 * h_ + 3] = tr_read(kb0 + ((ii) + h_) * 32 + 48 * KST); } } while (0)
            f32x4 nacc[2] = {{0.f, 0.f, 0.f, 0.f}, {0.f, 0.f, 0.f, 0.f}};
            KLOAD(0, 0);
#pragma unroll
            for (int ip = 0; ip < 8; ++ip) {
                const int i = 2 * ip;
                if (ip < 7) KLOAD((ip + 1) & 1, i + 2);
                C[i] *= decay; C[i + 1] *= decay;
                SB();
                C[i] = mfma16(cat8(ka[ip & 1][0], ka[ip & 1][1]), vw[0], C[i]);
                C[i + 1] = mfma16(cat8(ka[ip & 1][4], ka[ip & 1][5]), vw[0], C[i + 1]);
                C[i] = mfma16(cat8(ka[ip & 1][2], ka[ip & 1][3]), vw[1], C[i]);
                C[i + 1] = mfma16(cat8(ka[ip & 1][6], ka[ip & 1][7]), vw[1], C[i + 1]);
                if (ip == wid) {
                    nacc[0] = mfma16(cat8(ka[ip & 1][0], ka[ip & 1][1]), wn[0], nacc[0]); nacc[1] = mfma16(cat8(ka[ip & 1][4], ka[ip & 1][5]), wn[0], nacc[1]);
                    nacc[0] = mfma16(cat8(ka[ip & 1][2], ka[ip & 1][3]), wn[1], nacc[0]); nacc[1] = mfma16(cat8(ka[ip & 1][6], ka[ip & 1][7]), wn[1], nacc[1]);
                }
                SB();
            }
#undef KLOAD
            if (fr == 0) {
#pragma unroll
                for (int ii = 0; ii < 2; ++ii) { LAS f32x4* np = (LAS f32x4*)(NV + 32 * wid + 16 * ii + 4 * fq); const f32x4 o = *np * decay + nacc[ii]; *np = o;
                    u32x2 ob; ob.x = pk_bf16(o[0], o[1]); ob.y = pk_bf16(o[2], o[3]); *(LAS u32x2*)(lds + L_NB + (32 * wid + 8 * fq + 4 * ii) * 2) = ob; }
            }
        }
#undef SB
        lds_bar();
    }
    SCAN_OUT(nch - 1);
#undef SCAN_ISSUE
#undef SCAN_OUT
    float* Cout = p.out + O_CP + (((size_t)b * 4 + h) * 256) * 256 + eh * 128 + e0;
    const unsigned cl_off = (unsigned)(4 * fq * 256 + fr);
#pragma unroll
    for (int i = 0; i < 16; ++i)
#pragma unroll
        for (int j = 0; j < 4; ++j) __builtin_nontemporal_store(C[i][j], &(Cout + (size_t)i * 4096)[cl_off + j * 256]);
    if (eh == 0) {
        if (tid < 256) (p.out + O_NP)[((size_t)b * 4 + h) * 256 + tid] = NV[tid];
        if (tid == 0) (p.out + O_MP)[b * 4 + h] = MP[nch];
    }
    __syncthreads();
}

constexpr int SWR = 10240, SW_K = 0, SW_Q = 4224, SW_V = 8448, SW_F = 8832;
DI void sample_wave_unit(const Params& p, const int item, LAS unsigned char* wl) {
    int lane = threadIdx.x & 63; asm volatile("" : "+v"(lane));
    const int fr = lane & 15, fq = lane >> 4, rr = fr & 7;
    const int es = item & 15, h = (item >> 4) & 3, b = item >> 6, bh = b * 4 + h, e0 = 16 * es, rowbase = ROWS_P + b * 8;
    const float* GATES = (const float*)(p.ws + W_GATES);
    const bf16_t* Qg = (const bf16_t*)(p.ws + W_Q); const bf16_t* Kg = (const bf16_t*)(p.ws + W_K); const bf16_t* Vg = (const bf16_t*)(p.ws + W_V);
    bf16_t* HT = (bf16_t*)(p.ws + W_HT);
    LAS float* AL = (LAS float*)(wl + SW_F); LAS float* GG = AL + 8; LAS float* MM = AL + 16;
    f32x4 C[16];
    const unsigned cl_off = (unsigned)(4 * fq * 256 + fr);
    { const float* Cs = p.state_C + ((size_t)bh * 256) * 256 + e0;
#pragma unroll
      for (int i = 0; i < 16; ++i)
#pragma unroll
          for (int j = 0; j < 4; ++j) C[i][j] = (Cs + (size_t)i * 4096)[cl_off + j * 256]; }
    { const int r = lane >> 3, seg = lane & 7; const size_t grow = (size_t)(rowbase + r) * 1024 + h * 256;
#pragma unroll
      for (int i = 0; i < 4; ++i) { const int c16 = seg + 8 * i;
          *(LAS u32x4*)(wl + SW_K + r * QST + c16 * 16) = *(const u32x4*)(Kg + grow + c16 * 8);
          *(LAS u32x4*)(wl + SW_Q + r * QST + c16 * 16) = *(const u32x4*)(Qg + grow + c16 * 8); }
      if (lane < 16) { const int vr = lane >> 1, hf = lane & 1; *(LAS u32x4*)(wl + SW_V + vr * 48 + hf * 16) = *(const u32x4*)(Vg + (size_t)(rowbase + vr) * 1024 + h * 256 + e0 + hf * 8); } }
    const float mprev = p.state_m[bh];
    {
        const int t = lane & 7; const float* g = GATES + (size_t)(rowbase + t) * 8; const float ig = g[h]; float bs = g[4 + h];
#pragma unroll
        for (int o = 1; o < 8; o <<= 1) { const float v = __shfl_up(bs, o, 8); if (t >= o) bs += v; }
        const float gg = ig - bs; float P = gg;
#pragma unroll
        for (int o = 1; o < 8; o <<= 1) { const float v = __shfl_up(P, o, 8); if (t >= o) P = fmaxf(P, v); }
        const float mt = bs + fmaxf(mprev, P);
        if (lane < 8) { AL[t] = bs - mt; GG[t] = gg; MM[t] = mt; }
    }
    asm volatile("" ::: "memory");
    const float alast = AL[7], decay = __expf(alast + mprev), al_t = AL[rr];
    const f32x4 g4 = *(const LAS f32x4*)(GG + 4 * (fq & 1));
    f32x4 a = {0.f, 0.f, 0.f, 0.f};
#pragma unroll
    for (int kk = 0; kk < 8; ++kk) {
        const bf16x8 ak = *(const LAS bf16x8*)(wl + SW_K + rr * QST + (kk * 32 + fq * 8) * 2);
        const bf16x8 bq = *(const LAS bf16x8*)(wl + SW_Q + rr * QST + (kk * 32 + fq * 8) * 2);
        a = mfma16(ak, bq, a);
    }
    float w[4], rs = 0.f;
#pragma unroll
    for (int j = 0; j < 4; ++j) { const int sx = 4 * fq + j; w[j] = (fq < 2 && fr < 8 && sx <= fr) ? a[j] * __expf(al_t + g4[j]) : 0.f; rs += w[j]; }
    rs += __shfl_xor(rs, 16); rs += __shfl_xor(rs, 32);
    u32x4 swu; swu.x = pk_bf16(w[0], w[1]); swu.y = pk_bf16(w[2], w[3]); swu.z = 0u; swu.w = 0u;
    const bf16x8 swf = __builtin_bit_cast(bf16x8, swu);
    float qd = 0.f;
    {   const int part = lane >> 3; const float* nv = p.state_n + (size_t)bh * 256 + 32 * part;
#pragma unroll
        for (int i = 0; i < 4; ++i) { const bf16x8 q = *(const LAS bf16x8*)(wl + SW_Q + (lane & 7) * QST + (part * 4 + i) * 16);
            const float4 n0 = *(const float4*)(nv + 8 * i), n1 = *(const float4*)(nv + 8 * i + 4);
            qd += bf2f(q[0]) * n0.x + bf2f(q[1]) * n0.y + bf2f(q[2]) * n0.z + bf2f(q[3]) * n0.w + bf2f(q[4]) * n1.x + bf2f(q[5]) * n1.y + bf2f(q[6]) * n1.z + bf2f(q[7]) * n1.w; }
        qd += __shfl_xor(qd, 8); qd += __shfl_xor(qd, 16); qd += __shfl_xor(qd, 32); }
    const float inter = __expf(al_t + mprev);
    const float dn = __fdividef(1.f, fmaxf(fabsf(inter * qd + rs), __expf(-MM[rr])));
    f32x4 num = {0.f, 0.f, 0.f, 0.f};
#pragma unroll
    for (int kk = 0; kk < 8; ++kk) {
        u32x4 bc; bc.x = pk_bf16(C[2 * kk][0], C[2 * kk][1]); bc.y = pk_bf16(C[2 * kk][2], C[2 * kk][3]); bc.z = pk_bf16(C[2 * kk + 1][0], C[2 * kk + 1][1]); bc.w = pk_bf16(C[2 * kk + 1][2], C[2 * kk + 1][3]);
        const s16x4 lo = *(const LAS s16x4*)(wl + SW_Q + rr * QST + (32 * kk + 4 * fq) * 2);
        const s16x4 hi = *(const LAS s16x4*)(wl + SW_Q + rr * QST + (32 * kk + 16 + 4 * fq) * 2);
        num = mfma16(__builtin_bit_cast(bf16x8, bc), cat8(lo, hi), num);
    }
#pragma unroll
    for (int j = 0; j < 4; ++j) num[j] *= inter;
    const s16x4 zero4 = {0, 0, 0, 0};
    const s16x4 v4 = tr_read(wl + SW_V + (4 * (fq & 1) + (fr >> 2)) * 48 + (4 * (fr & 3)) * 2);
    num = mfma16(cat8(v4, zero4), swf, num);
    if (fr < 8) { u32x2 o; o.x = pk_bf16(num[0] * dn, num[1] * dn); o.y = pk_bf16(num[2] * dn, num[3] * dn);
        *(u32x2*)(HT + (size_t)(rowbase + fr) * 1024 + h * 256 + e0 + 4 * fq) = o; }
    u32x4 vwu; { float f[4];
#pragma unroll
        for (int j = 0; j < 4; ++j) f[j] = fq < 2 ? bf2f(v4[j]) * __expf(alast + g4[j]) : 0.f;
        vwu.x = pk_bf16(f[0], f[1]); vwu.y = pk_bf16(f[2], f[3]); vwu.z = 0u; vwu.w = 0u; }
    const bf16x8 vwf = __builtin_bit_cast(bf16x8, vwu);
    float* Cout = p.out + O_CS + ((size_t)bh * 256) * 256 + e0;
#pragma unroll
    for (int i = 0; i < 16; ++i) {
        const s16x4 k4 = tr_read(wl + SW_K + (4 * (fq & 1) + (fr >> 2)) * QST + (16 * i + 4 * (fr & 3)) * 2);
        C[i] = mfma16(cat8(k4, zero4), vwf, C[i] * decay);
#pragma unroll
        for (int j = 0; j < 4; ++j) __builtin_nontemporal_store(C[i][j], &(Cout + (size_t)i * 4096)[cl_off + j * 256]);
    }
    if (es == 0) {
        const float4 nn = *(const float4*)(p.state_n + (size_t)bh * 256 + 4 * lane);
        float n0 = decay * nn.x, n1 = decay * nn.y, n2 = decay * nn.z, n3 = decay * nn.w;
#pragma unroll
        for (int sx = 0; sx < 8; ++sx) { const float ws = __expf(alast + GG[sx]); const u32x2 kk = *(const LAS u32x2*)(wl + SW_K + sx * QST + lane * 8);
            n0 += ws * bf_lo(kk.x); n1 += ws * bf_hi(kk.x); n2 += ws * bf_lo(kk.y); n3 += ws * bf_hi(kk.y); }
        float4 o4; o4.x = n0; o4.y = n1; o4.z = n2; o4.w = n3;
        *(float4*)(p.out + O_NS + (size_t)bh * 256 + 4 * lane) = o4;
        if (lane == 0) (p.out + O_MS)[bh] = MM[7];
    }
    asm volatile("" ::: "memory");
}

DI void pool_unit(const Params& p, const int tile, const int g, LAS unsigned char* lds) {
    const int tid = opaque_tid(), lane = tid & 63, wid = __builtin_amdgcn_readfirstlane(tid >> 6), fr = lane & 15, fq = lane >> 4;
    const int w = 2 << g;
    const bf16_t* U = (const bf16_t*)(p.ws + W_U); const bf16_t* ZA = (const bf16_t*)(p.ws + W_ZA); bf16_t* Y = (bf16_t*)(p.ws + W_Y);
    bf16x8 bw[8][2];
    { const bf16_t* Wp = (const bf16_t*)(p.ws + W_WPOOL) + (size_t)g * 65536;
#pragma unroll
      for (int kk = 0; kk < 8; ++kk)
#pragma unroll
          for (int n = 0; n < 2; ++n) bw[kk][n] = *(const bf16x8*)(Wp + (size_t)(32 * wid + 16 * n + fr) * 256 + 32 * kk + 8 * fq); }
    __syncthreads();
    if (tile < ROWS_P / 64) {
        constexpr int L_US = L_K;
        const int R0 = tile * 64;
        for (int q = tid; q < 79 * 32; q += 512) { const int i = q >> 5, c16 = q & 31; int gr = R0 - 15 + i; gr = gr < 0 ? 0 : gr;
            *(LAS u32x4*)(lds + L_US + i * QST + c16 * 16) = *(const u32x4*)(U + (size_t)gr * 1024 + 256 * g + c16 * 8); }
        __syncthreads();
        for (int it = 0; it < 4; ++it) {
            const int item = tid + 512 * it, r = item >> 5, cg8 = item & 31;
            const int row = R0 + r, b = row / TPR, t = row - b * TPR, cnt = min(w, t + 1);
            float s[8], cur[8];
#pragma unroll
            for (int i = 0; i < 8; ++i) { s[i] = 0.f; cur[i] = 0.f; }
            for (int j = 0; j < cnt; ++j) {
                const u32x4 v = *(const LAS u32x4*)(lds + L_US + (r + 15 - j) * QST + cg8 * 16);
                const float f0 = bf_lo(v.x), f1 = bf_hi(v.x), f2 = bf_lo(v.y), f3 = bf_hi(v.y), f4 = bf_lo(v.z), f5 = bf_hi(v.z), f6 = bf_lo(v.w), f7 = bf_hi(v.w);
                s[0] += f0; s[1] += f1; s[2] += f2; s[3] += f3; s[4] += f4; s[5] += f5; s[6] += f6; s[7] += f7;
                if (j == 0) { cur[0] = f0; cur[1] = f1; cur[2] = f2; cur[3] = f3; cur[4] = f4; cur[5] = f5; cur[6] = f6; cur[7] = f7; }
            }
            const float inv = 1.f / (float)cnt;
            u32x4 o; o.x = pk_bf16(s[0] * inv - cur[0], s[1] * inv - cur[1]); o.y = pk_bf16(s[2] * inv - cur[2], s[3] * inv - cur[3]);
            o.z = pk_bf16(s[4] * inv - cur[4], s[5] * inv - cur[5]); o.w = pk_bf16(s[6] * inv - cur[6], s[7] * inv - cur[7]);
            *(LAS u32x4*)(lds + L_Q + r * QST + cg8 * 16) = o;
        }
    } else
    for (int it = 0; it < 4; ++it) {
        const int item = tid + 512 * it, r = item >> 5, cg8 = item & 31;
        const int row = tile * 64 + r, ch = 256 * g + 8 * cg8;
        const bool sample = row >= ROWS_P;
        int b, t, cnt;
        if (!sample) { b = row / TPR; t = row - b * TPR; cnt = min(w, t + 1); } else { const int si = row - ROWS_P; b = si >> 3; t = si & 7; cnt = w; }
        float s[8], cur[8];
#pragma unroll
        for (int i = 0; i < 8; ++i) { s[i] = 0.f; cur[i] = 0.f; }
        for (int j = 0; j < w; ++j) {
            if (j <= t) {
                const u32x4 v = *(const u32x4*)(U + (size_t)(row - j) * 1024 + ch);
                const float f0 = bf_lo(v.x), f1 = bf_hi(v.x), f2 = bf_lo(v.y), f3 = bf_hi(v.y), f4 = bf_lo(v.z), f5 = bf_hi(v.z), f6 = bf_lo(v.w), f7 = bf_hi(v.w);
                s[0] += f0; s[1] += f1; s[2] += f2; s[3] += f3; s[4] += f4; s[5] += f5; s[6] += f6; s[7] += f7;
                if (j == 0) { cur[0] = f0; cur[1] = f1; cur[2] = f2; cur[3] = f3; cur[4] = f4; cur[5] = f5; cur[6] = f6; cur[7] = f7; }
            } else if (sample) {
                const float* sp = p.state_pool + ((size_t)b * 15 + (15 + t - j)) * 1024 + ch;
                const float4 a = *(const float4*)sp, c4 = *(const float4*)(sp + 4);
                s[0] += a.x; s[1] += a.y; s[2] += a.z; s[3] += a.w; s[4] += c4.x; s[5] += c4.y; s[6] += c4.z; s[7] += c4.w;
            }
        }
        const float inv = 1.f / (float)cnt;
        u32x4 o; o.x = pk_bf16(s[0] * inv - cur[0], s[1] * inv - cur[1]); o.y = pk_bf16(s[2] * inv - cur[2], s[3] * inv - cur[3]);
        o.z = pk_bf16(s[4] * inv - cur[4], s[5] * inv - cur[5]); o.w = pk_bf16(s[6] * inv - cur[6], s[7] * inv - cur[7]);
        *(LAS u32x4*)(lds + L_Q + r * QST + cg8 * 16) = o;
    }
    __syncthreads();
    f32x4 acc[4][2];
#pragma unroll
    for (int mt = 0; mt < 4; ++mt) { acc[mt][0] = (f32x4){0.f, 0.f, 0.f, 0.f}; acc[mt][1] = (f32x4){0.f, 0.f, 0.f, 0.f}; }
    {
        bf16x8 af[2][4];
#pragma unroll
        for (int mt = 0; mt < 4; ++mt) af[0][mt] = *(const LAS bf16x8*)(lds + L_Q + (16 * mt + fr) * QST + (8 * fq) * 2);
#pragma unroll
        for (int kk = 0; kk < 8; ++kk) {
            if (kk < 7) {
#pragma unroll
                for (int mt = 0; mt < 4; ++mt) af[(kk + 1) & 1][mt] = *(const LAS bf16x8*)(lds + L_Q + (16 * mt + fr) * QST + (32 * (kk + 1) + 8 * fq) * 2);
            }
            __builtin_amdgcn_sched_barrier(0);
#pragma unroll
            for (int mt = 0; mt < 4; ++mt)
#pragma unroll
                for (int n = 0; n < 2; ++n) acc[mt][n] = mfma16(bw[kk][n], af[kk & 1][mt], acc[mt][n]);
            __builtin_amdgcn_sched_barrier(0);
        }
    }
#pragma unroll
    for (int mt = 0; mt < 4; ++mt) {
        const int row = tile * 64 + 16 * mt + fr;
#pragma unroll
        for (int n = 0; n < 2; ++n) {
            const int d = 256 * g + 32 * wid + 16 * n + 4 * fq;
            const u32x2 za = *(const u32x2*)(ZA + (size_t)row * 1024 + d);
            u32x2 o; o.x = pk_bf16(acc[mt][n][0] * bf_lo(za.x), acc[mt][n][1] * bf_hi(za.x)); o.y = pk_bf16(acc[mt][n][2] * bf_lo(za.y), acc[mt][n][3] * bf_hi(za.y));
            *(u32x2*)(Y + (size_t)row * 2048 + d) = o;
        }
    }
}

constexpr int N_ITEMS2 = 8192;
DI void gemm1_run(const Params& p, LAS unsigned char* lds, int G, int c, int first, int last) {
    pg8::Gemm g; g.A = (const bf16_t*)(p.ws + W_XN); g.Bt = (const bf16_t*)(p.ws + W_WIN); g.M = TP; g.N = 7168; g.K = 1024;
    SegOrder S; S.G = G; S.c = c; S.first = first; S.last = last;
    EpiG1 E; E.U = (bf16_t*)(p.ws + W_U); E.ZA = (bf16_t*)(p.ws + W_ZA); E.Q = (bf16_t*)(p.ws + W_Q); E.K = (bf16_t*)(p.ws + W_K); E.V = (bf16_t*)(p.ws + W_V); E.G = (bf16_t*)(p.ws + W_G); E.pool_scale = p.pool_scale;
    pg8::gemm_phase<EpiG1, SegOrder, false>(lds, g, S, E, nullptr);
}
constexpr int G1_SPLIT = 1536, N_SCAN_WG = 64;
DI void phase2(const Params& p, LAS unsigned char* lds, int rep) {
    if ((int)blockIdx.x < N_SCAN_WG) {
        for (int rr = 0; rr < ((PROBE_DUP & 64) ? 2 : 1); ++rr)
        for (int u = blockIdx.x; u < 64; u += N_SCAN_WG) { const int eh = (u >> 3) & 1, bh = (u & 7) + 8 * (u >> 4); scan_unit(p, bh >> 2, bh & 3, eh, lds); }
    } else {
        gemm1_run(p, lds, (int)gridDim.x - N_SCAN_WG, (int)blockIdx.x - N_SCAN_WG, G1_SPLIT, 1932);
        __syncthreads();
        for (int i = (int)blockIdx.x - N_SCAN_WG; i < NU0_WOUT; i += (int)gridDim.x - N_SCAN_WG) { const int pn = i >> 5, kb = i & 31;
            p0_transpose(p.w_out, 1024, 256 * pn, 256 * pn + 128, false, 1.f, (bf16_t*)(p.ws + W_WOUT) + (size_t)pn * 256 * 2048, 2048, 64 * kb, lds); }
    }
    __syncthreads();
    {
        unsigned* pctr = (unsigned*)(p.ws + W_CTR) + 8 + rep;
        for (;;) {
            __syncthreads();
            if (threadIdx.x == 0) *(LAS int*)(lds + L_CTL) = (int)atomicAdd(pctr, 1u);
            __syncthreads();
            const int pt = *(const LAS int*)(lds + L_CTL);
            if (pt >= 1096) break;
            pool_unit(p, pt >> 2, pt & 3, lds);
        }
        __syncthreads();
    }
    const int wv = __builtin_amdgcn_readfirstlane((int)(threadIdx.x >> 6));
    for (int qq = 0; qq < ((PROBE_DUP & 128) ? 2 : 1); ++qq) {
    unsigned* ctr = (unsigned*)(p.ws + W_CTR) + rep + 2 * qq;
    for (;;) {
        int item = 0;
        if ((threadIdx.x & 63) == 0) item = (int)atomicAdd(ctr, 1u);
        item = __builtin_amdgcn_readfirstlane(item);
        if (item >= N_ITEMS2) break;
        sample_wave_unit(p, item, lds + wv * SWR);
    }
    }
}

DI void ln_finish(const Params& p, int r, int lane, const u32x4 h0, const u32x4 h1, const u32x4 g0, const u32x4 g1) {
    bf16_t* Y = (bf16_t*)(p.ws + W_Y);
    const int ch = 16 * lane;
    float v[16] = {bf_lo(h0.x), bf_hi(h0.x), bf_lo(h0.y), bf_hi(h0.y), bf_lo(h0.z), bf_hi(h0.z), bf_lo(h0.w), bf_hi(h0.w),
                   bf_lo(h1.x), bf_hi(h1.x), bf_lo(h1.y), bf_hi(h1.y), bf_lo(h1.z), bf_hi(h1.z), bf_lo(h1.w), bf_hi(h1.w)};
    float s = 0.f;
#pragma unroll
    for (int i = 0; i < 16; ++i) s += v[i];
    s += __shfl_xor(s, 1); s += __shfl_xor(s, 2); s += __shfl_xor(s, 4); s += __shfl_xor(s, 8);
    const float mu = s * (1.f / 256.f);
    float q = 0.f;
#pragma unroll
    for (int i = 0; i < 16; ++i) { v[i] -= mu; q += v[i] * v[i]; }
    q += __shfl_xor(q, 1); q += __shfl_xor(q, 2); q += __shfl_xor(q, 4); q += __shfl_xor(q, 8);
    const float rstd = rsqrtf(q * (1.f / 256.f) + 1e-6f);
    const float gg[16] = {bf_lo(g0.x), bf_hi(g0.x), bf_lo(g0.y), bf_hi(g0.y), bf_lo(g0.z), bf_hi(g0.z), bf_lo(g0.w), bf_hi(g0.w),
                          bf_lo(g1.x), bf_hi(g1.x), bf_lo(g1.y), bf_hi(g1.y), bf_lo(g1.z), bf_hi(g1.z), bf_lo(g1.w), bf_hi(g1.w)};
    float o[16];
#pragma unroll
    for (int i = 0; i < 4; ++i) { const float4 w4 = *(const float4*)(p.mhln_w + ch + 4 * i);
        o[4 * i] = v[4 * i] * rstd * w4.x * gg[4 * i]; o[4 * i + 1] = v[4 * i + 1] * rstd * w4.y * gg[4 * i + 1];
        o[4 * i + 2] = v[4 * i + 2] * rstd * w4.z * gg[4 * i + 2]; o[4 * i + 3] = v[4 * i + 3] * rstd * w4.w * gg[4 * i + 3]; }
    u32x4 a, c;
    a.x = pk_bf16(o[0], o[1]); a.y = pk_bf16(o[2], o[3]); a.z = pk_bf16(o[4], o[5]); a.w = pk_bf16(o[6], o[7]);
    c.x = pk_bf16(o[8], o[9]); c.y = pk_bf16(o[10], o[11]); c.z = pk_bf16(o[12], o[13]); c.w = pk_bf16(o[14], o[15]);
    *(u32x4*)(Y + (size_t)r * 2048 + 1024 + ch) = a; *(u32x4*)(Y + (size_t)r * 2048 + 1024 + ch + 8) = c;
}
DI void phase3(const Params& p, LAS unsigned char* lds) {
    (void)lds;
    const int tid = opaque_tid(), lane = tid & 63, wid = __builtin_amdgcn_readfirstlane(tid >> 6);
    const bf16_t* HT = (const bf16_t*)(p.ws + W_HT); const bf16_t* G = (const bf16_t*)(p.ws + W_G); const bf16_t* U = (const bf16_t*)(p.ws + W_U);
    const int stride = gridDim.x * 8, ch = 16 * lane;
    for (int r = blockIdx.x * 8 + wid; r < T; r += 2 * stride) {
        const int r2 = r + stride < T ? r + stride : r;
        const u32x4 h0 = *(const u32x4*)(HT + (size_t)r * 1024 + ch), h1 = *(const u32x4*)(HT + (size_t)r * 1024 + ch + 8);
        const u32x4 g0 = *(const u32x4*)(G + (size_t)r * 1024 + ch), g1 = *(const u32x4*)(G + (size_t)r * 1024 + ch + 8);
        const u32x4 h2 = *(const u32x4*)(HT + (size_t)r2 * 1024 + ch), h3 = *(const u32x4*)(HT + (size_t)r2 * 1024 + ch + 8);
        const u32x4 g2 = *(const u32x4*)(G + (size_t)r2 * 1024 + ch), g3 = *(const u32x4*)(G + (size_t)r2 * 1024 + ch + 8);
        ln_finish(p, r, lane, h0, h1, g0, g1);
        if (r2 != r) ln_finish(p, r2, lane, h2, h3, g2, g3);
    }
    for (int i = blockIdx.x * 512 + tid; i < 16384; i += gridDim.x * 512) ((float*)(p.ws + W_RSS))[i] = 0.f;
    const int gtid = (int)blockIdx.x * 512 + tid, gstr = (int)gridDim.x * 512;
    for (int i = gtid; i < 122880 / 4; i += gstr) { const int c = (i & 255) * 4, ri = i >> 8, b = ri / 15, k = ri - b * 15;
        const u32x2 v = *(const u32x2*)(U + (size_t)(b * TPR + 2049 + k) * 1024 + c);
        f32x4 o; o[0] = bf_lo(v.x); o[1] = bf_hi(v.x); o[2] = bf_lo(v.y); o[3] = bf_hi(v.y);
        __builtin_nontemporal_store(o, (f32x4*)(p.out + O_PP + (size_t)i * 4)); }
    for (int i = gtid; i < 1966080 / 4; i += gstr) { const int c = (i & 255) * 4, ri = i >> 8, b = ri / 15, k = ri - b * 15;
        f32x4 o;
        if (k < 7) o = __builtin_nontemporal_load((const f32x4*)(p.state_pool + ((size_t)b * 15 + 8 + k) * 1024 + c));
        else { const u32x2 v = *(const u32x2*)(U + (size_t)(ROWS_P + b * 8 + k - 7) * 1024 + c); o[0] = bf_lo(v.x); o[1] = bf_hi(v.x); o[2] = bf_lo(v.y); o[3] = bf_hi(v.y); }
        __builtin_nontemporal_store(o, (f32x4*)(p.out + O_PS + (size_t)i * 4)); }
}

DI void p5_load(const Params& p, int o, int lane, float4 (&v)[4]) {
    const int R = o < 16384 ? (o >> 11) * TPR + (o & 2047) + NMETA : ROWS_P + (o - 16384);
    if (R >= 16384) {
        const float* xr = o < 16384 ? p.x_prompt + (size_t)o * 1024 : p.x_sample + (size_t)(o - 16384) * 1024;
        const float* pp = (const float*)(p.ws + W_Q) + (size_t)(R - 16384) * 1024;
#pragma unroll
        for (int j = 0; j < 4; ++j) { v[j] = *(const float4*)(xr + 4 * lane + 256 * j);
#pragma unroll
            for (int ks = 0; ks < 8; ++ks) { const float4 q = *(const float4*)(pp + (size_t)ks * 1280 * 1024 + 4 * lane + 256 * j); v[j].x += q.x; v[j].y += q.y; v[j].z += q.z; v[j].w += q.w; } }
    } else {
        const float* row = p.out + (size_t)o * 1024;
#pragma unroll
        for (int j = 0; j < 4; ++j) v[j] = *(const float4*)(row + 4 * lane + 256 * j);
    }
}
DI void p5_finish(const Params& p, int o, int lane, float4 (&v)[4]) {
    float ss = 0.f;
#pragma unroll
    for (int j = 0; j < 4; ++j) ss += v[j].x * v[j].x + v[j].y * v[j].y + v[j].z * v[j].z + v[j].w * v[j].w;
    ss = wave_sum(ss);
    const float rstd = rsqrtf(ss * (1.f / 1024.f) + 1e-6f);
    float* row = p.out + (size_t)o * 1024;
#pragma unroll
    for (int j = 0; j < 4; ++j) { const float4 w = *(const float4*)(p.normf_w + 4 * lane + 256 * j);
        f32x4 o_; o_[0] = v[j].x * rstd * w.x; o_[1] = v[j].y * rstd * w.y; o_[2] = v[j].z * rstd * w.z; o_[3] = v[j].w * rstd * w.w; __builtin_nontemporal_store(o_, (f32x4*)(row + 4 * lane + 256 * j)); }
}
DI void phase5(const Params& p) {
    const int tid = opaque_tid(), lane = tid & 63, wid = __builtin_amdgcn_readfirstlane(tid >> 6);
    const int N = 16384 + 1024, stride = gridDim.x * 8;
    for (int o = 16256 + blockIdx.x * 8 + wid; o < N; o += 2 * stride) {
        const int o2 = o + stride; const bool has2 = o2 < N;
        float4 va[4], vb[4];
        p5_load(p, o, lane, va);
        if (has2) p5_load(p, o2, lane, vb);
        p5_finish(p, o, lane, va);
        if (has2) p5_finish(p, o2, lane, vb);
    }
}

DI void run_phase(const Params& p, int ph, LAS unsigned char* lds, int rep = 0) {
    if (ph == 0) phase0(p, lds);
    else if (ph == 1) { gemm1_run(p, lds, (int)gridDim.x, (int)blockIdx.x, 0, G1_SPLIT);
    } else if (ph == 2) phase2(p, lds, rep);
    else if (ph == 3) phase3(p, lds);
    else if (ph == 4) {
        pg8::Gemm g; g.A = (const bf16_t*)(p.ws + W_Y); g.Bt = (const bf16_t*)(p.ws + W_WOUT); g.M = TP; g.N = 1024; g.K = 2048;
        G2Order S; S.G = (int)gridDim.x; S.c = (int)blockIdx.x;
        EpiG2 E; E.x_prompt = p.x_prompt; E.xs_delta = (long)(p.x_sample - p.x_prompt); E.out = p.out; E.part = (float*)(p.ws + W_Q); E.rss = (float*)(p.ws + W_RSS); E.pcnt = (unsigned*)(p.ws + W_BAR) + 3456; E.normf_w = p.normf_w;
        pg8::gemm_phase<EpiG2, G2Order, false>(lds, g, S, E, nullptr);
    } else phase5(p);
}

template <bool COOP, int PH> __global__ __launch_bounds__(512, 2) void hymba_mega(Params p) {
    extern __shared__ __attribute__((aligned(16))) unsigned char smem[];
    LAS unsigned char* lds = (LAS unsigned char*)smem;
    if constexpr (COOP) {
        cg::grid_group grid = cg::this_grid();
        if (p.phase_hi == 777) grid.sync();
        if (threadIdx.x == 0) { *(LAS unsigned*)(lds + L_XB) = 0u; *(LAS unsigned*)(lds + L_XB + 4) = 0u; }
        __syncthreads();
        const XcdBarrier xb = xcd_barrier_post((unsigned*)(p.ws + W_BAR), (volatile LAS unsigned*)(lds + L_XB));
#define GSYNC() xcd_barrier(xb)
#define RUNPH(k) do { run_phase(p, k, lds); if (PROBE_DUP & (1 << k)) { GSYNC(); run_phase(p, k, lds, 1); } } while (0)
        RUNPH(0); GSYNC(); RUNPH(1); GSYNC(); RUNPH(2); GSYNC(); RUNPH(3); GSYNC(); RUNPH(4); GSYNC();
        if (PROBE_DUP & 32) { run_phase(p, 4, lds, 1); GSYNC(); }
        if (PROBE_DUP & 256) { GSYNC(); GSYNC(); GSYNC(); GSYNC(); }
        run_phase(p, 5, lds);
    } else {
        run_phase(p, PH, lds);
    }
}

extern "C" void kernel_launch(void* const* d_in, const int* in_sizes, int n_in, void* d_out, int out_size, void* d_ws, size_t ws_size, hipStream_t stream) {
    (void)in_sizes; (void)n_in; (void)out_size; (void)ws_size;
    Params p{};
    p.x_prompt = (const float*)d_in[0]; p.x_sample = (const float*)d_in[1]; p.state_pool = (const float*)d_in[2]; p.state_C = (const float*)d_in[3];
    p.state_n = (const float*)d_in[4]; p.state_m = (const float*)d_in[5]; p.meta = (const float*)d_in[6]; p.norm1_w = (const float*)d_in[7];
    p.w_in = (const float*)d_in[8]; p.b_if = (const float*)d_in[9]; p.w_pool = (const float*)d_in[10]; p.pool_scale = (const float*)d_in[11];
    p.mhln_w = (const float*)d_in[12]; p.w_out = (const float*)d_in[13]; p.normf_w = (const float*)d_in[14];
    p.out = (float*)d_out; p.ws = (unsigned char*)d_ws;
    static int grid_blocks = 0;
    if (!grid_blocks) {
        int dev = 0, cus = 0, per_cu = 0;
        (void)hipGetDevice(&dev);
        (void)hipDeviceGetAttribute(&cus, hipDeviceAttributeMultiprocessorCount, dev);
#if MK_MULTI
        (void)hipFuncSetAttribute((const void*)hymba_mega<false, 0>, hipFuncAttributeMaxDynamicSharedMemorySize, LDS_BYTES);
        (void)hipFuncSetAttribute((const void*)hymba_mega<false, 1>, hipFuncAttributeMaxDynamicSharedMemorySize, LDS_BYTES);
        (void)hipFuncSetAttribute((const void*)hymba_mega<false, 2>, hipFuncAttributeMaxDynamicSharedMemorySize, LDS_BYTES);
        (void)hipFuncSetAttribute((const void*)hymba_mega<false, 3>, hipFuncAttributeMaxDynamicSharedMemorySize, LDS_BYTES);
        (void)hipFuncSetAttribute((const void*)hymba_mega<false, 4>, hipFuncAttributeMaxDynamicSharedMemorySize, LDS_BYTES);
        (void)hipFuncSetAttribute((const void*)hymba_mega<false, 5>, hipFuncAttributeMaxDynamicSharedMemorySize, LDS_BYTES);
        per_cu = 1;
#else
        (void)hipFuncSetAttribute((const void*)hymba_mega<true, 0>, hipFuncAttributeMaxDynamicSharedMemorySize, LDS_BYTES);
        (void)hipOccupancyMaxActiveBlocksPerMultiprocessor(&per_cu, hymba_mega<true, 0>, 512, LDS_BYTES);
#endif
        if (per_cu < 1) per_cu = 1;
        grid_blocks = cus * per_cu;
    }
#if MK_MULTI
    hipLaunchKernelGGL((hymba_mega<false, 0>), dim3(grid_blocks), dim3(512), LDS_BYTES, stream, p);
    hipLaunchKernelGGL((hymba_mega<false, 1>), dim3(grid_blocks), dim3(512), LDS_BYTES, stream, p);
    hipLaunchKernelGGL((hymba_mega<false, 2>), dim3(grid_blocks), dim3(512), LDS_BYTES, stream, p);
    hipLaunchKernelGGL((hymba_mega<false, 3>), dim3(grid_blocks), dim3(512), LDS_BYTES, stream, p);
    hipLaunchKernelGGL((hymba_mega<false, 4>), dim3(grid_blocks), dim3(512), LDS_BYTES, stream, p);
    hipLaunchKernelGGL((hymba_mega<false, 5>), dim3(grid_blocks), dim3(512), LDS_BYTES, stream, p);
#else
    p.phase_lo = 0; p.phase_hi = 5;
    (void)hipMemsetAsync((unsigned char*)d_ws + W_CTR, 0, 256 + 16384, stream);
    void* args[] = {&p};
    hipError_t e = hipLaunchCooperativeKernel((const void*)hymba_mega<true, 0>, dim3(grid_blocks), dim3(512), args, LDS_BYTES, stream);
    if (e != hipSuccess) fprintf(stderr, "cooperative launch failed: %s (grid %d)\n", hipGetErrorString(e), grid_blocks);
#endif
}
```

```cpp
#include <hip/hip_runtime.h>
#include <hip/hip_cooperative_groups.h>
#include <cstdio>
#ifndef PROBE_DUP
#define PROBE_DUP 0
#endif
#ifndef MK_MULTI
#define MK_MULTI 0
#endif
namespace pg8 {
#define PG8_LAS __attribute__((address_space(3)))
typedef unsigned short bf16_t;
typedef short bf16x8 __attribute__((ext_vector_type(8)));
typedef float f32x4 __attribute__((ext_vector_type(4)));
typedef unsigned u32x4 __attribute__((ext_vector_type(4)));
constexpr int BM = 256, BK = 64, HALF = 128, HTB = HALF * BK * 2  , STAGE_BYTES = 8 * HTB, NXCD = 8, WGM = 8;

__host__ __device__ __forceinline__ int lds_byte(int r, int c) { const int st = (r >> 4) * 2 + (c >> 5), rr = r & 15, cc = c & 31, ob = rr * 64 + cc * 2; return st * 1024 + (ob ^ (((ob >> 9) & 1) << 5)); }
__host__ __device__ __forceinline__ void stage_rc(int b, int& R, int& C) { const int st = b / 1024, sb = b % 1024, swz = sb ^ (((sb >> 9) & 1) << 5); R = (st >> 1) * 16 + swz / 64; C = (st & 1) * 32 + (swz % 64) / 2; }
__host__ __device__ __forceinline__ int perm32(int rho) { const int n = rho >> 4, i = rho & 15; return 8 * (i >> 2) + 4 * n + (i & 3); }

struct Unit { int pm, pn, koff, klen; };
struct Gemm { const bf16_t* A; const bf16_t* Bt; int M, N, K; };

struct StaticOrder {
    int nM, nN, nwg, G, c;
    __host__ __device__ void init(int M, int N, int G_, int c_) { nM = M / BM; nN = N / BM; nwg = nM * nN; G = G_; c = c_; }
    __host__ __device__ bool next(int i, Unit& u) const {
        const long L = (long)i * G + c; if (L >= nwg) return false;
        int wgid = (int)L; { const int q = nwg / NXCD, r = nwg % NXCD, xcd = wgid % NXCD, off = wgid / NXCD; wgid = (xcd < r ? xcd * (q + 1) : r * (q + 1) + (xcd - r) * q) + off; }
        const int nig = WGM * nN, gid = wgid / nig, fm = gid * WGM, gsz = (nM - fm) < WGM ? (nM - fm) : WGM;
        u.pm = fm + ((wgid % nig) % gsz); u.pn = (wgid % nig) / gsz; u.koff = 0; u.klen = 0; return true;
    }
    __device__ __forceinline__ void a_ready(const Unit&) const {}
    __device__ __forceinline__ void done(const Unit&) const {}
};

template <class Epi, class Sched, bool STAMP = false>
__device__ __forceinline__ void gemm_phase(PG8_LAS unsigned char* lds, const Gemm g, const Sched& S, const Epi& E, unsigned long long* stamps) {
    int tid_ = threadIdx.x; asm volatile("" : "+v"(tid_)); const int tid = tid_, wid = __builtin_amdgcn_readfirstlane(tid >> 6), lane = tid & 63, wr = wid >> 2, wc = wid & 3, fr = lane & 15, fq = lane >> 4;
    const int K = g.K, nt = K / BK;
    int ts_lo = 0, ts_hi = 0, nts = 0; const unsigned long long rt_entry = STAMP ? (unsigned long long)wall_clock64() : 0ull;
#define PG8_STAMP() do { if (STAMP && wid == 0 && nts < 64) { const unsigned long long _c = (unsigned long long)clock64(); \
        ts_lo = (lane == nts) ? (int)(unsigned)_c : ts_lo; ts_hi = (lane == nts) ? (int)(unsigned)(_c >> 32) : ts_hi; ++nts; } } while (0)
    PG8_STAMP();
    unsigned voffA[2], voffB[2];
#pragma unroll
    for (int i = 0; i < 2; ++i) { int R, C; stage_rc(tid * 16 + i * 8192, R, C); const int Rb = Epi::PERM ? ((R & ~31) + perm32(R & 31)) : R;
        voffA[i] = (unsigned)(R * K + C) * 2u; voffB[i] = (unsigned)(Rb * K + C) * 2u; }
    const size_t kstep = (size_t)(BK * 2);
    const size_t hstep = (size_t)HALF * K * 2;
    const size_t tstep = 2 * hstep;
    const unsigned ldsw = (unsigned)wid * 1024u;
    const int aoff = lds_byte(wr * 64 + fr, fq * 8), boff = lds_byte(wc * 32 + fr, fq * 8);
#define PG8_SA(b, h) (((b) * 2 + (h)) * HTB)
#define PG8_SB(b, h) ((4 + (b) * 2 + (h)) * HTB)
#define PG8_STAGE(bufoff, gbase, voff) do { _Pragma("unroll") for (int _i = 0; _i < 2; ++_i) \
        __builtin_amdgcn_global_load_lds((const unsigned*)((const char*)(gbase) + (voff)[_i]), (PG8_LAS unsigned*)(lds + (bufoff) + ldsw + _i * 8192), 16, 0, 0); } while (0)
#define PG8_LDA(dst, b, h) do { _Pragma("unroll") for (int m = 0; m < 4; ++m) _Pragma("unroll") for (int k = 0; k < 2; ++k) dst[m][k] = *(const PG8_LAS bf16x8*)(lds + PG8_SA(b, h) + aoff + m * 2048 + k * 1024); } while (0)
#define PG8_LDB(dst, b, h) do { _Pragma("unroll") for (int n = 0; n < 2; ++n) _Pragma("unroll") for (int k = 0; k < 2; ++k) dst[n][k] = *(const PG8_LAS bf16x8*)(lds + PG8_SB(b, h) + boff + n * 2048 + k * 1024); } while (0)
#define PG8_MMA(ai, bj, At, Bt) do { __builtin_amdgcn_s_setprio(1); _Pragma("unroll") for (int m = 0; m < 4; ++m) _Pragma("unroll") for (int n = 0; n < 2; ++n) _Pragma("unroll") for (int k = 0; k < 2; ++k) \
        acc[ai][bj][m][n] = __builtin_amdgcn_mfma_f32_16x16x32_bf16(Bt[n][k], At[m][k], acc[ai][bj][m][n], 0, 0, 0); __builtin_amdgcn_s_setprio(0); } while (0)
#define PG8_WAIT_V(n) asm volatile("s_waitcnt vmcnt(" #n ")" ::: "memory")
#define PG8_WAIT_L(n) asm volatile("s_waitcnt lgkmcnt(" #n ")" ::: "memory")
#define PG8_BAR __builtin_amdgcn_s_barrier()
#define PG8_SCHED __builtin_amdgcn_sched_barrier(0)
    Unit cur, nxt; int ui = 0;
    if (!S.next(0, cur)) return;
    f32x4 acc[2][2][4][2];
#pragma unroll
    for (int a = 0; a < 2; ++a)
#pragma unroll
        for (int b = 0; b < 2; ++b)
#pragma unroll
            for (int m = 0; m < 4; ++m)
#pragma unroll
                for (int n = 0; n < 2; ++n) acc[a][b][m][n] = (f32x4){0.f, 0.f, 0.f, 0.f};
    bf16x8 At[4][2], B0[2][2], B1[2][2];
    const char* cA = (const char*)g.A + (size_t)cur.pm * tstep + (size_t)cur.koff * 2; const char* cB = (const char*)g.Bt + (size_t)cur.pn * tstep + (size_t)cur.koff * 2;
    S.a_ready(cur);
    PG8_STAGE(PG8_SB(0, 0), cB, voffB); PG8_STAGE(PG8_SA(0, 0), cA, voffA); PG8_STAGE(PG8_SB(0, 1), cB + hstep, voffB); PG8_STAGE(PG8_SA(0, 1), cA + hstep, voffA);
    if (wr == 1) PG8_BAR;
    PG8_WAIT_V(4); PG8_BAR;
    PG8_STAGE(PG8_SB(1, 0), cB + kstep, voffB); PG8_STAGE(PG8_SA(1, 0), cA + kstep, voffA); PG8_STAGE(PG8_SB(1, 1), cB + hstep + kstep, voffB);
    PG8_WAIT_V(6); PG8_BAR;
    PG8_STAMP();
    for (;;) {
        const bool has_next = S.next(ui + 1, nxt);
        const char* nA = has_next ? (const char*)g.A + (size_t)nxt.pm * tstep + (size_t)nxt.koff * 2 : cA; const char* nB = has_next ? (const char*)g.Bt + (size_t)nxt.pn * tstep + (size_t)nxt.koff * 2 : cB;
        const int ntc = cur.klen ? cur.klen / BK : nt;
        for (int t = 0; t < ntc; t += 2) {
            const bool last = (t == ntc - 2);
            const char* a1 = cA + (size_t)(t + 1) * kstep;
            const char* a2 = last ? nA : cA + (size_t)(t + 2) * kstep; const char* b2 = last ? nB : cB + (size_t)(t + 2) * kstep;
            const char* a3 = a2 + kstep; const char* b3 = b2 + kstep;
            if (last && has_next) S.a_ready(nxt);
            PG8_LDB(B0, 0, 0); PG8_SCHED; PG8_LDA(At, 0, 0); PG8_STAGE(PG8_SA(1, 1), a1 + hstep, voffA);
            PG8_WAIT_L(8); PG8_BAR; PG8_WAIT_L(0); PG8_MMA(0, 0, At, B0); PG8_BAR; PG8_SCHED;
            PG8_LDB(B1, 0, 1); PG8_STAGE(PG8_SB(0, 0), b2, voffB);
            PG8_BAR; PG8_WAIT_L(0); PG8_MMA(0, 1, At, B1); PG8_BAR;
            PG8_LDA(At, 0, 1); PG8_STAGE(PG8_SA(0, 0), a2, voffA);
            PG8_BAR; PG8_WAIT_L(0); PG8_MMA(1, 0, At, B0); PG8_BAR; PG8_SCHED;
            PG8_STAGE(PG8_SB(0, 1), b2 + hstep, voffB);
            PG8_WAIT_V(6); PG8_BAR; PG8_MMA(1, 1, At, B1); PG8_BAR;
            PG8_LDB(B0, 1, 0); PG8_SCHED; PG8_LDA(At, 1, 0); PG8_STAGE(PG8_SA(0, 1), a2 + hstep, voffA);
            PG8_WAIT_L(8); PG8_BAR; PG8_WAIT_L(0); PG8_MMA(0, 0, At, B0); PG8_BAR; PG8_SCHED;
            PG8_LDB(B1, 1, 1); PG8_STAGE(PG8_SB(1, 0), b3, voffB);
            PG8_BAR; PG8_WAIT_L(0); PG8_MMA(0, 1, At, B1); PG8_BAR;
            PG8_LDA(At, 1, 1); PG8_STAGE(PG8_SA(1, 0), a3, voffA);
            PG8_BAR; PG8_WAIT_L(0); PG8_MMA(1, 0, At, B0); PG8_BAR; PG8_SCHED;
            PG8_STAGE(PG8_SB(1, 1), b3 + hstep, voffB);
            PG8_WAIT_V(6); PG8_BAR; PG8_MMA(1, 1, At, B1); PG8_BAR;
        }
        PG8_STAMP();
        if constexpr (!Epi::AFTER_DRAIN) { E(acc, cur, wr, wc, fr, fq); S.done(cur); }
        PG8_STAMP();
        if (!has_next) break;
#pragma unroll
        for (int a = 0; a < 2; ++a)
#pragma unroll
            for (int b = 0; b < 2; ++b)
#pragma unroll
                for (int m = 0; m < 4; ++m)
#pragma unroll
                    for (int n = 0; n < 2; ++n) acc[a][b][m][n] = (f32x4){0.f, 0.f, 0.f, 0.f};
        cur = nxt; cA = nA; cB = nB; ++ui;
    }
    PG8_WAIT_V(0);
    if (wr == 0) PG8_BAR;
    PG8_BAR;
    if constexpr (Epi::AFTER_DRAIN) { E.fused(acc, cur, wr, wc, fr, fq, lds, wid, lane); S.done(cur); }
    PG8_STAMP();
    if (STAMP && wid == 0) { stamps[lane] = lane < nts ? (((unsigned long long)(unsigned)ts_hi << 32) | (unsigned)ts_lo) : 0ull;
        if (lane == 62) stamps[62] = rt_entry; if (lane == 63) stamps[63] = (unsigned long long)wall_clock64(); }
#undef PG8_STAMP
#undef PG8_SA
#undef PG8_SB
#undef PG8_STAGE
#undef PG8_LDA
#undef PG8_LDB
#undef PG8_MMA
#undef PG8_WAIT_V
#undef PG8_WAIT_L
#undef PG8_BAR
#undef PG8_SCHED
}
}
namespace cg = cooperative_groups;
using pg8::bf16_t; using pg8::bf16x8; using pg8::f32x4; using pg8::u32x4; using pg8::Unit;
#define LAS __attribute__((address_space(3)))
typedef short s16x4 __attribute__((ext_vector_type(4)));
typedef unsigned u32x2 __attribute__((ext_vector_type(2)));
typedef __bf16 bf2_t __attribute__((ext_vector_type(2)));
typedef float f2_t __attribute__((ext_vector_type(2)));
#define DI __device__ __forceinline__

constexpr int DM = 1024, SEQ = 2048, NMETA = 16, TPR = 2064, ROWS_P = 16512, ROWS_S = 1024, T = 17536, TP = 17664;
constexpr int DPROJ = 7176;
constexpr size_t O_YP = 0, O_YS = 16777216, O_PP = O_YS + 1048576, O_CP = O_PP + 122880, O_NP = O_CP + 2097152, O_MP = O_NP + 8192,
                 O_PS = O_MP + 32, O_CS = O_PS + 1966080, O_NS = O_CS + 33554432, O_MS = O_NS + 131072;
constexpr size_t SZ_ACT = (size_t)TP * 1024 * 2;
constexpr size_t W_XN = 0, W_WIN = W_XN + SZ_ACT, W_WOUT = W_WIN + (size_t)7168 * 1024 * 2, W_WPOOL = W_WOUT + (size_t)1024 * 2048 * 2,
                 W_GATES = W_WPOOL + 524288, W_U = W_GATES + (size_t)TP * 32, W_ZA = W_U + SZ_ACT, W_Q = W_ZA + SZ_ACT, W_K = W_Q + SZ_ACT,
                 W_V = W_K + SZ_ACT, W_G = W_V + SZ_ACT, W_HT = W_G + SZ_ACT, W_Y = W_HT + SZ_ACT, W_RSS = W_Y + 2 * SZ_ACT,
                 W_CTR = W_RSS + (size_t)TP * 64, W_BAR = W_CTR + 256, W_END = W_BAR + 16384;
constexpr int LDS_BYTES = 143872 + 16, L_XB = 143872;

struct Params {
    const float *x_prompt, *x_sample, *state_pool, *state_C, *state_n, *state_m, *meta, *norm1_w, *w_in, *b_if, *w_pool, *pool_scale, *mhln_w, *w_out, *normf_w;
    float* out;
    unsigned char* ws;
    int phase_lo, phase_hi;
};

DI int opaque_tid() { int t = threadIdx.x; asm volatile("" : "+v"(t)); return t; }
DI unsigned pk_bf16(float lo, float hi) { f2_t v = {lo, hi}; bf2_t r = __builtin_convertvector(v, bf2_t); return __builtin_bit_cast(unsigned, r); }
DI float bf_lo(unsigned u) { return __uint_as_float(u << 16); }
DI float bf_hi(unsigned u) { return __uint_as_float(u & 0xffff0000u); }
DI float bf2f(short s) { return __uint_as_float(((unsigned)(unsigned short)s) << 16); }
DI float wave_sum(float v) { for (int o = 32; o; o >>= 1) v += __shfl_xor(v, o); return v; }
DI float sigmoidf_(float x) { return __fdividef(1.f, 1.f + __expf(-x)); }
DI float siluf_(float x) { return x * sigmoidf_(x); }
DI float gate2_(float o, float z) { return z * __builtin_amdgcn_rcpf((1.f + __expf(-o)) * (1.f + __expf(-z))); }
DI f32x4 mfma16(bf16x8 a, bf16x8 b, f32x4 c) { return __builtin_amdgcn_mfma_f32_16x16x32_bf16(a, b, c, 0, 0, 0); }
DI s16x4 tr_read(const LAS unsigned char* a) { return __builtin_amdgcn_ds_read_tr16_b64_v4i16((LAS s16x4*)a); }
DI bf16x8 cat8(s16x4 lo, s16x4 hi) { return __builtin_shufflevector(lo, hi, 0, 1, 2, 3, 4, 5, 6, 7); }

#define XB_TMO      128
#define XB_XCNT(j)  (256  + 64 * (j))
#define XB_XSUB(j)  (1280 + 64 * (j))
#define XB_XGEN(j)  (2304 + 64 * (j))
#define XB_TOP      3328
#define XB_TOPGEN   3392
#define XCD_BAR_WORDS 3456
#define XB_SPIN_CAP (1u << 18)

__device__ __forceinline__ unsigned xb_ld(unsigned* p)              { return __hip_atomic_load(p, __ATOMIC_RELAXED, __HIP_MEMORY_SCOPE_AGENT); }
__device__ __forceinline__ unsigned xb_add(unsigned* p, unsigned v) { return __hip_atomic_fetch_add(p, v, __ATOMIC_RELAXED, __HIP_MEMORY_SCOPE_AGENT); }
__device__ __forceinline__ unsigned xb_xcc_id() { return (unsigned)__builtin_amdgcn_s_getreg((3 << 11) | 20) & 0xFu; }
#define XB_SPIN(cond, bar) do { unsigned _sp = 0; while (cond) { __builtin_amdgcn_s_sleep(1); \
    if ((++_sp & 255u) == 0u) { if (xb_ld(&(bar)[XB_TMO])) break; if (_sp > XB_SPIN_CAP) { atomicAdd(&(bar)[XB_TMO], 1u); break; } } } } while (0)

struct XcdBarrier {
    unsigned* bar; unsigned x;
    volatile LAS unsigned* st;
};

__device__ __forceinline__ XcdBarrier xcd_barrier_post(unsigned* bar, volatile LAS unsigned* st) {
    XcdBarrier b; b.bar = bar; b.x = xb_xcc_id(); b.st = st;
    if (threadIdx.x == 0) (void)xb_add(&bar[XB_XCNT(b.x)], 1u);
    return b;
}
__device__ __forceinline__ void xcd_barrier_complete(unsigned* bar, unsigned x, unsigned& nloc, unsigned& nx) {
    const unsigned G = gridDim.x * gridDim.y * gridDim.z;
    unsigned sum, cnt, mine, sp = 0u;
    for (;;) {
        sum = 0u; cnt = 0u; mine = 0u;
#pragma unroll
        for (unsigned j = 0; j < 16; ++j) { const unsigned c = xb_ld(&bar[XB_XCNT(j)]); sum += c; cnt += (c > 0u) ? 1u : 0u; mine = (j == x) ? c : mine; }
        if (sum == G) break;
        __builtin_amdgcn_s_sleep(1);
        if ((++sp & 255u) == 0u) { if (xb_ld(&bar[XB_TMO])) break; if (sp > XB_SPIN_CAP) { atomicAdd(&bar[XB_TMO], 1u); break; } }
    }
    nloc = mine > 0u ? mine : 1u; nx = cnt > 0u ? cnt : 1u;
}

__device__ __forceinline__ void xcd_barrier(const XcdBarrier& b) {
    asm volatile("s_waitcnt vmcnt(0)" ::: "memory");
    __syncthreads();
    if (threadIdx.x == 0) {
        unsigned* bar = b.bar;
        __builtin_amdgcn_s_waitcnt(0);
        unsigned nloc = b.st[0], nx = b.st[1];
        if (nloc == 0u) { xcd_barrier_complete(bar, b.x, nloc, nx); b.st[0] = nloc; b.st[1] = nx; }
        const unsigned old = xb_add(&bar[XB_XSUB(b.x)], 1u);
        const unsigned gen = old / nloc;
        if (old + 1u == (gen + 1u) * nloc) {
            __builtin_amdgcn_fence(__ATOMIC_RELEASE, "agent");
            asm volatile("s_waitcnt vmcnt(0)" ::: "memory");
            const unsigned og = xb_add(&bar[XB_TOP], 1u);
            const unsigned tg = og / nx;
            if (og + 1u == (tg + 1u) * nx) xb_add(&bar[XB_TOPGEN], 1u);
            else XB_SPIN(xb_ld(&bar[XB_TOPGEN]) == tg, bar);
            __builtin_amdgcn_fence(__ATOMIC_ACQUIRE, "agent");
            xb_add(&bar[XB_XGEN(b.x)], 1u);
            asm volatile("s_waitcnt vmcnt(0)" ::: "memory");
        } else {
            XB_SPIN(xb_ld(&bar[XB_XGEN(b.x)]) == gen, bar);
            __builtin_amdgcn_fence(__ATOMIC_ACQUIRE, "agent");
            asm volatile("s_waitcnt vmcnt(0)" ::: "memory");
        }
    }
    __syncthreads();
}


DI const float* row_src(const Params& p, int r) {
    if (r < ROWS_P) { const int b = r / TPR, t = r - b * TPR; return t < NMETA ? p.meta + (size_t)t * DM : p.x_prompt + ((size_t)(b * SEQ + t - NMETA)) * DM; }
    return p.x_sample + (size_t)(r - ROWS_P) * DM;
}

DI void p0_rows(const Params& p, int u, LAS unsigned char* lds, const float4 (&wa)[4][4], const float4 (&wb)[4][4]) {
    (void)lds;
    const int tid = opaque_tid(), lane = tid & 63, wid = __builtin_amdgcn_readfirstlane(tid >> 6);
    bf16_t* XN = (bf16_t*)(p.ws + W_XN); float* GATES = (float*)(p.ws + W_GATES);
    const int rbase = u * 32 + wid * 4;
    float4 x[4][4]; float ss[4];
#pragma unroll
    for (int q = 0; q < 4; ++q) {
        const int r = rbase + q; const float* src = row_src(p, r < T ? r : T - 1);
#pragma unroll
        for (int j = 0; j < 4; ++j) { const f32x4 t_ = __builtin_nontemporal_load((const f32x4*)(src + 4 * lane + 256 * j)); x[q][j].x = t_[0]; x[q][j].y = t_[1]; x[q][j].z = t_[2]; x[q][j].w = t_[3]; }
    }
#pragma unroll
    for (int q = 0; q < 4; ++q) { float a = 0.f;
#pragma unroll
        for (int j = 0; j < 4; ++j) a += x[q][j].x * x[q][j].x + x[q][j].y * x[q][j].y + x[q][j].z * x[q][j].z + x[q][j].w * x[q][j].w;
        ss[q] = a; }
#pragma unroll
    for (int o = 32; o; o >>= 1) {
#pragma unroll
        for (int q = 0; q < 4; ++q) ss[q] += __shfl_xor(ss[q], o); }
#pragma unroll
    for (int q = 0; q < 4; ++q) {
        const int r = rbase + q;
        if (r >= T) { const u32x4 z = {0u, 0u, 0u, 0u}; *(u32x4*)(XN + (size_t)r * 1024 + lane * 16) = z; *(u32x4*)(XN + (size_t)r * 1024 + lane * 16 + 8) = z; continue; }
        const float rstd = rsqrtf(ss[q] * (1.f / 1024.f) + 1e-6f);
        float ga[8];
#pragma unroll
        for (int g = 0; g < 8; ++g) ga[g] = 0.f;
#pragma unroll
        for (int j = 0; j < 4; ++j) {
            const float4 nw = *(const float4*)(p.norm1_w + 4 * lane + 256 * j);
            float y[4]; y[0] = x[q][j].x * rstd * nw.x; y[1] = x[q][j].y * rstd * nw.y; y[2] = x[q][j].z * rstd * nw.z; y[3] = x[q][j].w * rstd * nw.w;
            u32x2 o; o.x = pk_bf16(y[0], y[1]); o.y = pk_bf16(y[2], y[3]);
            *(u32x2*)(XN + (size_t)r * 1024 + 4 * lane + 256 * j) = o;
#pragma unroll
            for (int e = 0; e < 4; ++e) { ga[0] += y[e] * wa[j][e].x; ga[1] += y[e] * wa[j][e].y; ga[2] += y[e] * wa[j][e].z; ga[3] += y[e] * wa[j][e].w;
                                          ga[4] += y[e] * wb[j][e].x; ga[5] += y[e] * wb[j][e].y; ga[6] += y[e] * wb[j][e].z; ga[7] += y[e] * wb[j][e].w; }
        }
        float h4[4], h2[2], h1;
        { const bool up = lane & 32;
#pragma unroll
          for (int g = 0; g < 4; ++g) { const float keep = up ? ga[4 + g] : ga[g], give = up ? ga[g] : ga[4 + g]; h4[g] = keep + __shfl_xor(give, 32); } }
        { const bool up = lane & 16;
#pragma unroll
          for (int g = 0; g < 2; ++g) { const float keep = up ? h4[2 + g] : h4[g], give = up ? h4[g] : h4[2 + g]; h2[g] = keep + __shfl_xor(give, 16); } }
        { const bool up = lane & 8; const float keep = up ? h2[1] : h2[0], give = up ? h2[0] : h2[1]; h1 = keep + __shfl_xor(give, 8); }
        h1 += __shfl_xor(h1, 4); h1 += __shfl_xor(h1, 2); h1 += __shfl_xor(h1, 1);
        if ((lane & 7) == 0) {
            const int g = ((lane >> 5) & 1) * 4 + ((lane >> 4) & 1) * 2 + ((lane >> 3) & 1);
            const float v = h1 + p.b_if[g];
            GATES[(size_t)r * 8 + g] = g < 4 ? v : fminf(v, 0.f) - log1pf(__expf(-fabsf(v)));
        }
    }
}

DI void p0_transpose(const float* src, int src_pitch, int cb0, int cb1, bool perm, float scale, bf16_t* dst, int dst_pitch, int k0, LAS unsigned char* lds) {
    LAS float* tile = (LAS float*)lds;
    const int tid = opaque_tid();
    const int c4 = (tid & 63) * 4, r0 = tid >> 6;
    const int scol = c4 < 128 ? cb0 + c4 : cb1 + c4 - 128;
#pragma unroll
    for (int i = 0; i < 8; ++i) { const int row = r0 + 8 * i; const f32x4 v = __builtin_nontemporal_load((const f32x4*)(src + (size_t)(k0 + row) * src_pitch + scol));
        tile[row * 257 + c4 + 0] = v[0]; tile[row * 257 + c4 + 1] = v[1]; tile[row * 257 + c4 + 2] = v[2]; tile[row * 257 + c4 + 3] = v[3]; }
    __syncthreads();
    const int kg = tid & 7;
#pragma unroll
    for (int i = 0; i < 4; ++i) {
        const int r = (tid >> 3) + 64 * i;
        const int c = perm ? ((r & ~31) + pg8::perm32(r & 31)) : r;
        float v[8];
#pragma unroll
        for (int j = 0; j < 8; ++j) v[j] = tile[(kg * 8 + j) * 257 + c] * scale;
        u32x4 o; o.x = pk_bf16(v[0], v[1]); o.y = pk_bf16(v[2], v[3]); o.z = pk_bf16(v[4], v[5]); o.w = pk_bf16(v[6], v[7]);
        *(u32x4*)(dst + (size_t)r * dst_pitch + k0 + kg * 8) = o;
    }
    __syncthreads();
}

constexpr int NU0_ROWS = TP / 32  , NU0_WIN = 28 * 16, NU0_WOUT = 4 * 32, NU0_WPOOL = 4 * 4, NU0 = NU0_ROWS + NU0_WIN + NU0_WPOOL;
DI void phase0(const Params& p, LAS unsigned char* lds) {
    if (blockIdx.x == 0 && threadIdx.x < 8) ((unsigned*)(p.ws + W_CTR))[threadIdx.x] = 0u;
    float4 wa[4][4], wb[4][4];
    {   const int lane_ = threadIdx.x & 63;
#pragma unroll
        for (int j = 0; j < 4; ++j)
#pragma unroll
            for (int e = 0; e < 4; ++e) { const float* wp = p.w_in + (size_t)(4 * lane_ + 256 * j + e) * DPROJ + 7168; wa[j][e] = *(const float4*)wp; wb[j][e] = *(const float4*)(wp + 4); } }
    for (int u = blockIdx.x; u < NU0; u += gridDim.x) {
        if (u < NU0_ROWS) p0_rows(p, u, lds, wa, wb);
        else if (u < NU0_ROWS + NU0_WIN) { const int i = u - NU0_ROWS, pn = i >> 4, kb = i & 15;
            const int cb0 = pn < 20 ? 256 * pn : 5120 + 128 * (pn - 20), cb1 = pn < 20 ? 256 * pn + 128 : 6144 + 128 * (pn - 20);
            p0_transpose(p.w_in, DPROJ, cb0, cb1, true, (pn >= 12 && pn < 16) ? 0.0625f : 1.f, (bf16_t*)(p.ws + W_WIN) + (size_t)pn * 256 * 1024, 1024, 64 * kb, lds); }
        else { const int i = u - NU0_ROWS - NU0_WIN, g = i >> 2, kb = i & 3;
            p0_transpose(p.w_pool + (size_t)g * 65536, 256, 0, 128, false, 1.f, (bf16_t*)(p.ws + W_WPOOL) + (size_t)g * 65536, 256, 64 * kb, lds); }
    }
}


struct SegOrder {
    int G, c, first, last;
    __device__ __forceinline__ static void map(int l, int nN, Unit& u) {
        const int nM = 69, nwg = nM * nN; int wgid = l;
        { const int q = nwg / 8, r = nwg % 8, xcd = wgid % 8, off = wgid / 8; wgid = (xcd < r ? xcd * (q + 1) : r * (q + 1) + (xcd - r) * q) + off; }
        const int nig = 8 * nN, gid = wgid / nig, fm = gid * 8, gsz = (nM - fm) < 8 ? (nM - fm) : 8;
        u.pm = fm + ((wgid % nig) % gsz); u.pn = (wgid % nig) / gsz; u.koff = 0; u.klen = 0;
    }
    __device__ __forceinline__ bool next(int i, Unit& u) const {
        const int L = first + i * G + c; if (L >= last) return false;
        if (L < 1380) map(L, 20, u); else { map(L - 1380, 8, u); u.pn += 20; }
        return true;
    }
    __device__ __forceinline__ void a_ready(const Unit&) const {}
    __device__ __forceinline__ void done(const Unit&) const {}
};
struct EpiG1 {
    static constexpr bool PERM = false, AFTER_DRAIN = false;
    bf16_t *U, *ZA, *Q, *K, *V, *G; const float* pool_scale;
    DI void operator()(const f32x4 (&acc)[2][2][4][2], const Unit& u, int wr, int wc, int fr, int fq) const {
        const int row0 = u.pm * 256 + wr * 64 + fr, cl = wc * 32 + 8 * fq;
        if (u.pn >= 20) {
            const int col = (u.pn - 20) * 128 + cl;
#pragma unroll
            for (int ai = 0; ai < 2; ++ai)
#pragma unroll
                for (int m = 0; m < 4; ++m) {
                    const int row = row0 + ai * 128 + m * 16;
                    float r[8];
#pragma unroll
                    for (int i = 0; i < 4; ++i) { r[i] = gate2_(acc[ai][0][m][0][i], acc[ai][1][m][0][i]); r[4 + i] = gate2_(acc[ai][0][m][1][i], acc[ai][1][m][1][i]); }
                    u32x4 o; o.x = pk_bf16(r[0], r[1]); o.y = pk_bf16(r[2], r[3]); o.z = pk_bf16(r[4], r[5]); o.w = pk_bf16(r[6], r[7]);
                    *(u32x4*)(G + (size_t)row * 1024 + col) = o;
                }
        } else {
            const int tsel = u.pn >> 2;
            bf16_t* base = tsel == 0 ? U : tsel == 1 ? ZA : tsel == 2 ? Q : tsel == 3 ? K : V;
#pragma unroll
            for (int bj = 0; bj < 2; ++bj) {
                const int col = (u.pn & 3) * 256 + bj * 128 + cl;
                float ps[8];
                if (tsel == 1) { const float4 a = *(const float4*)(pool_scale + col), b = *(const float4*)(pool_scale + col + 4); ps[0] = a.x; ps[1] = a.y; ps[2] = a.z; ps[3] = a.w; ps[4] = b.x; ps[5] = b.y; ps[6] = b.z; ps[7] = b.w; }
#pragma unroll
                for (int ai = 0; ai < 2; ++ai)
#pragma unroll
                    for (int m = 0; m < 4; ++m) {
                        const int row = row0 + ai * 128 + m * 16;
                        float r[8];
#pragma unroll
                        for (int i = 0; i < 4; ++i) { r[i] = acc[ai][bj][m][0][i]; r[4 + i] = acc[ai][bj][m][1][i]; }
                        if (tsel == 1) {
#pragma unroll
                            for (int i = 0; i < 8; ++i) r[i] = siluf_(r[i]) * ps[i];
                        }
                        u32x4 o; o.x = pk_bf16(r[0], r[1]); o.y = pk_bf16(r[2], r[3]); o.z = pk_bf16(r[4], r[5]); o.w = pk_bf16(r[6], r[7]);
                        *(u32x4*)(base + (size_t)row * 1024 + col) = o;
                    }
            }
        }
    }
};

struct G2Order {
    int G, c;
    __device__ __forceinline__ bool next(int i, Unit& u) const {
        const int L = i * G + c;
        if (L < 256) { u.pm = L >> 2; u.pn = L & 3; u.koff = 0; u.klen = 0; return true; }
        const int idx = L - 256; if (idx >= 160) return false;
        const int tile = idx >> 3; u.pm = 64 + (tile >> 2); u.pn = tile & 3; u.koff = (idx & 7) * 256; u.klen = 256; return true;
    }
    __device__ __forceinline__ void a_ready(const Unit&) const {}
    __device__ __forceinline__ void done(const Unit&) const {}
};
struct EpiG2 {
    static constexpr bool PERM = false, AFTER_DRAIN = false;
    const float* x_prompt; long xs_delta; float* out; float* part; float* rss; unsigned* pcnt; const float* normf_w;
    DI void operator()(const f32x4 (&acc)[2][2][4][2], const Unit& u, int wr, int wc, int fr, int fq) const {
        const int row0 = u.pm * 256 + wr * 64 + fr, col0 = u.pn * 256 + wc * 32 + 4 * fq;
        if (u.klen != 0) {
#pragma unroll
            for (int ai = 0; ai < 2; ++ai)
#pragma unroll
                for (int m = 0; m < 4; ++m) {
                    const int row = row0 + ai * 128 + m * 16;
                    if (row < T) { float* pp = part + ((size_t)(u.koff >> 8) * 1280 + (row - 16384)) * 1024;
#pragma unroll
                        for (int bj = 0; bj < 2; ++bj)
#pragma unroll
                            for (int n = 0; n < 2; ++n) { const int c = col0 + bj * 128 + n * 16; *(f32x4*)(pp + c) = acc[ai][bj][m][n]; } }
                }
            return;
        }
        f32x4 (&va)[2][2][4][2] = const_cast<f32x4 (&)[2][2][4][2]>(acc);
#pragma unroll
        for (int ai = 0; ai < 2; ++ai)
#pragma unroll
            for (int m = 0; m < 4; ++m) {
                const int row = row0 + ai * 128 + m * 16;
                const int b = row / TPR, t = row - b * TPR; const bool valid = t >= NMETA;
                const float* xin = x_prompt + ((long)(b * SEQ + t - NMETA)) * 1024;
                float ss = 0.f;
                if (valid) {
#pragma unroll
                    for (int bj = 0; bj < 2; ++bj)
#pragma unroll
                        for (int n = 0; n < 2; ++n) { const int c = col0 + bj * 128 + n * 16; const f32x4 v = va[ai][bj][m][n] + __builtin_nontemporal_load((const f32x4*)(xin + c)); va[ai][bj][m][n] = v; ss += v[0] * v[0] + v[1] * v[1] + v[2] * v[2] + v[3] * v[3]; }
                }
                ss += __shfl_xor(ss, 16); ss += __shfl_xor(ss, 32);
                if (valid && fq == 0) (void)__hip_atomic_fetch_add(rss + row, ss, __ATOMIC_RELAXED, __HIP_MEMORY_SCOPE_AGENT);
            }
        unsigned* cnt = pcnt + (u.pm * 2 + wr) * 4;
        asm volatile("s_waitcnt vmcnt(0)" ::: "memory");
        if ((threadIdx.x & 63) == 0) (void)__hip_atomic_fetch_add(cnt, 1u, __ATOMIC_RELAXED, __HIP_MEMORY_SCOPE_AGENT);
        for (unsigned sp = 0; sp < (1u << 22); ++sp) {
            const unsigned seen = (unsigned)__builtin_amdgcn_readfirstlane((int)__hip_atomic_load(cnt, __ATOMIC_RELAXED, __HIP_MEMORY_SCOPE_AGENT));
            if (seen >= 16u) break;
            __builtin_amdgcn_s_sleep(1);
        }
        asm volatile("" ::: "memory");
        f32x4 nw[2][2];
#pragma unroll
        for (int bj = 0; bj < 2; ++bj)
#pragma unroll
            for (int n = 0; n < 2; ++n) nw[bj][n] = *(const f32x4*)(normf_w + col0 + bj * 128 + n * 16);
#pragma unroll
        for (int ai = 0; ai < 2; ++ai)
#pragma unroll
            for (int m = 0; m < 4; ++m) {
                const int row = row0 + ai * 128 + m * 16;
                const int b = row / TPR, t = row - b * TPR; const bool valid = t >= NMETA;
                const long off = ((long)(b * SEQ + t - NMETA)) * 1024;
                if (valid) {
                    const float tot = __hip_atomic_load(rss + row, __ATOMIC_RELAXED, __HIP_MEMORY_SCOPE_AGENT);
                    const float rstd = rsqrtf(tot * (1.f / 1024.f) + 1e-6f);
#pragma unroll
                    for (int bj = 0; bj < 2; ++bj)
#pragma unroll
                        for (int n = 0; n < 2; ++n) { const int c = col0 + bj * 128 + n * 16;
                            __builtin_nontemporal_store(va[ai][bj][m][n] * rstd * nw[bj][n], (f32x4*)(out + off + c)); }
                }
            }
    }
};

constexpr int L_Q = 0, L_K = 33792, L_V = 68608, L_SW = 87040, L_AL = 96256, L_GG = 104704, L_MM = 113152, L_MP = 121600, L_NV = 121856,
              L_QD = 122880, L_DEN = 123136, L_WE = 123392, L_BL = 123648, L_PL = 123904, L_CTL = 124160, L_NB = 124416, L_NZ = 124928, L_OUT = 125440;
constexpr int QST = 528, KST = 544, VST = 288, SST = 144;

DI void lds_bar() { asm volatile("s_waitcnt lgkmcnt(0)" ::: "memory"); __builtin_amdgcn_s_barrier(); asm volatile("" ::: "memory"); }

DI void scan_unit(const Params& p, const int b, const int h, const int eh, LAS unsigned char* lds) {
    const int tid = opaque_tid(), lane = tid & 63, wid = __builtin_amdgcn_readfirstlane(tid >> 6), fr = lane & 15, fq = lane >> 4;
    constexpr int nch = 33;
    const int rowbase = b * TPR;
    const int ecol = h * 256 + eh * 128, e0 = 16 * wid;
    LAS float* AL = (LAS float*)(lds + L_AL); LAS float* GG = (LAS float*)(lds + L_GG); LAS float* MM = (LAS float*)(lds + L_MM); LAS float* MP = (LAS float*)(lds + L_MP);
    LAS float* NV = (LAS float*)(lds + L_NV); LAS float* QD = (LAS float*)(lds + L_QD); LAS float* DEN = (LAS float*)(lds + L_DEN);
    LAS float* BL = (LAS float*)(lds + L_BL); LAS float* PL = (LAS float*)(lds + L_PL);
    const float* GATES = (const float*)(p.ws + W_GATES);
    const bf16_t* Qg = (const bf16_t*)(p.ws + W_Q); const bf16_t* Kg = (const bf16_t*)(p.ws + W_K); const bf16_t* Vg = (const bf16_t*)(p.ws + W_V);
    bf16_t* HT = (bf16_t*)(p.ws + W_HT);
    constexpr int npos = nch * 64;
    const int ldr = tid >> 3, ldseg = tid & 7;
    u32x4 pq[4], pk[4], pv[2];
    const u32x4 z4 = {0u, 0u, 0u, 0u};
#define SCAN_ISSUE(cc) do { const int L_ = (cc) == 0 ? 16 : 64, t0_ = (cc) == 0 ? 0 : 16 + 64 * ((cc) - 1); const size_t grow_ = (size_t)(rowbase + t0_ + ldr) * 1024; \
        _Pragma("unroll") for (int i_ = 0; i_ < 4; ++i_) { pq[i_] = z4; pk[i_] = z4; if (ldr < L_) { pq[i_] = *(const u32x4*)(Qg + grow_ + h * 256 + (ldseg + 8 * i_) * 8); pk[i_] = *(const u32x4*)(Kg + grow_ + h * 256 + (ldseg + 8 * i_) * 8); } } \
        _Pragma("unroll") for (int i_ = 0; i_ < 2; ++i_) { pv[i_] = z4; if (ldr < L_) pv[i_] = *(const u32x4*)(Vg + grow_ + ecol + (ldseg + 8 * i_) * 8); } } while (0)
    SCAN_ISSUE(0);
    __syncthreads();
    for (int idx = tid; idx < npos; idx += 512) {
        const int c = idx >> 6, i = idx & 63;
        const int L = c == 0 ? 16 : 64;
        const int t = c == 0 ? i : 16 + 64 * (c - 1) + i;
        float lf = 0.f, ig = -INFINITY;
        if (i < L) { const float* g = GATES + (size_t)(rowbase + t) * 8; ig = g[h]; lf = g[4 + h]; }
        AL[idx] = lf; GG[idx] = ig;
    }
    if (tid < 256) { NV[tid] = 0.f; *(LAS unsigned*)(lds + L_NB + tid * 4) = 0u; }
    __syncthreads();
    if (tid < nch) {
        const int c = tid; const int L = c == 0 ? 16 : 64;
        float bs = 0.f, P = -INFINITY;
        for (int i = 0; i < L; ++i) { const int idx = c * 64 + i; bs += AL[idx]; const float g = GG[idx] - bs; P = fmaxf(P, g); AL[idx] = bs; GG[idx] = g; MM[idx] = P; }
        BL[c] = bs; PL[c] = P;
    }
    __syncthreads();
    if (tid == 0) { float m = 0.f; MP[0] = m; for (int c = 0; c < nch; ++c) { m = BL[c] + fmaxf(m, PL[c]); MP[c + 1] = m; } }
    __syncthreads();
    for (int idx = tid; idx < npos; idx += 512) {
        const int c = idx >> 6, i = idx & 63;
        const int L = c == 0 ? 16 : 64;
        if (i < L) { const float bt = AL[idx]; const float mt = bt + fmaxf(MP[c], MM[idx]); AL[idx] = bt - mt; MM[idx] = mt; }
        else { AL[idx] = 0.f; MM[idx] = 0.f; }
    }
    f32x4 C[16];
#pragma unroll
    for (int i = 0; i < 16; ++i) C[i] = (f32x4){0.f, 0.f, 0.f, 0.f};
    __syncthreads();
#define SCAN_OUT(cc) do { const int L_ = (cc) == 0 ? 16 : 64, t0_ = (cc) == 0 ? 0 : 16 + 64 * ((cc) - 1); const float dn_ = DEN[ldr]; \
        _Pragma("unroll") for (int i_ = 0; i_ < 2; ++i_) { const u32x4 v_ = *(const LAS u32x4*)(lds + L_OUT + ldr * VST + (ldseg + 8 * i_) * 16); u32x4 o_; \
            o_.x = pk_bf16(bf_lo(v_.x) * dn_, bf_hi(v_.x) * dn_); o_.y = pk_bf16(bf_lo(v_.y) * dn_, bf_hi(v_.y) * dn_); o_.z = pk_bf16(bf_lo(v_.z) * dn_, bf_hi(v_.z) * dn_); o_.w = pk_bf16(bf_lo(v_.w) * dn_, bf_hi(v_.w) * dn_); \
            if (ldr < L_) *(u32x4*)(HT + (size_t)(rowbase + t0_ + ldr) * 1024 + ecol + (ldseg + 8 * i_) * 8) = o_; } } while (0)
    for (int c = 0; c < nch; ++c) {
        const int L = c == 0 ? 16 : 64;
        const int gi = c * 64;
#pragma unroll
        for (int i = 0; i < 4; ++i) {
            const int c16 = ldseg + 8 * i, blk = c16 >> 2, g4 = (c16 & 3) * 2;
            const int s0 = 2 * (g4 & 3) + (g4 >> 2), s1 = 2 * ((g4 + 1) & 3) + ((g4 + 1) >> 2);
            u32x2 qa_, qb_; qa_.x = pq[i].x; qa_.y = pq[i].y; qb_.x = pq[i].z; qb_.y = pq[i].w;
            *(LAS u32x2*)(lds + L_Q + ldr * QST + blk * 64 + s0 * 8) = qa_; *(LAS u32x2*)(lds + L_Q + ldr * QST + blk * 64 + s1 * 8) = qb_;
            *(LAS u32x4*)(lds + L_K + ldr * KST + c16 * 16) = pk[i]; }
#pragma unroll
        for (int i = 0; i < 2; ++i) *(LAS u32x4*)(lds + L_V + ldr * VST + (ldseg + 8 * i) * 16) = pv[i];
        if (c + 1 < nch) SCAN_ISSUE(c + 1);
        lds_bar();
#define SB() __builtin_amdgcn_sched_barrier(0)
        {
            const int tt = wid >> 1;
            bf16x8 bq[8];
#pragma unroll
            for (int kk = 0; kk < 8; ++kk) { const LAS unsigned char* qp = lds + L_Q + (16 * tt + fr) * QST + kk * 64 + ((((fq & 1) << 2) | (fq >> 1)) * 8);
                bq[kk] = cat8(*(const LAS s16x4*)qp, *(const LAS s16x4*)(qp + 16)); }
#pragma unroll
            for (int si = 0; si < 2; ++si) {
                const int st = 2 * (wid & 1) + si;
                u32x2 outv = {0u, 0u};
                if (st <= tt) {
                    bf16x8 ak[8];
#pragma unroll
                    for (int kk = 0; kk < 8; ++kk) ak[kk] = *(const LAS bf16x8*)(lds + L_K + (16 * st + fr) * KST + (kk * 32 + fq * 8) * 2);
                    const int t = 16 * tt + fr; const float al = AL[gi + t];
                    const f32x4 g4 = *(const LAS f32x4*)(GG + gi + 16 * st + 4 * fq);
                    SB();
                    f32x4 a = {0.f, 0.f, 0.f, 0.f}, a2 = {0.f, 0.f, 0.f, 0.f};
#pragma unroll
                    for (int kk = 0; kk < 8; kk += 2) { a = mfma16(ak[kk], bq[kk], a); a2 = mfma16(ak[kk + 1], bq[kk + 1], a2); }
                    a += a2;
                    float w[4];
#pragma unroll
                    for (int j = 0; j < 4; ++j) { const int sx = 16 * st + 4 * fq + j; w[j] = (sx <= t) ? a[j] * __expf(al + g4[j]) : 0.f; }
                    outv.x = pk_bf16(w[0], w[1]); outv.y = pk_bf16(w[2], w[3]);
                }
                *(LAS u32x2*)(lds + L_SW + (16 * tt + fr) * SST + (16 * st + 4 * fq) * 2) = outv;
                SB();
            }
        }
        f32x4 num[4];
#pragma unroll
        for (int mt = 0; mt < 4; ++mt) num[mt] = (f32x4){0.f, 0.f, 0.f, 0.f};
        {
            bf16x8 qf[2][4], nf[2], pf[2]; f32x4 qacc = {0.f, 0.f, 0.f, 0.f};
            const bool qdw = wid < 4;
            const LAS unsigned char* nbp = lds + (fr == 0 ? L_NB : L_NZ) + (8 * fq) * 2;
            const LAS unsigned char* qdp = lds + L_Q + (16 * (wid & 3) + fr) * QST + (8 * fq) * 2;
#define QLOAD(buf, k_) do { _Pragma("unroll") for (int mt = 0; mt < 4; ++mt) qf[buf][mt] = *(const LAS bf16x8*)(lds + L_Q + (16 * mt + fr) * QST + (32 * (k_) + 8 * fq) * 2); \
                if (qdw) { nf[buf] = *(const LAS bf16x8*)(nbp + (k_) * 64); pf[buf] = *(const LAS bf16x8*)(qdp + (k_) * 64); } } while (0)
            QLOAD(0, 0);
#pragma unroll
            for (int kk = 0; kk < 8; ++kk) {
                if (kk < 7) QLOAD((kk + 1) & 1, kk + 1);
                u32x4 bc; bc.x = pk_bf16(C[2 * kk][0], C[2 * kk][1]); bc.y = pk_bf16(C[2 * kk][2], C[2 * kk][3]); bc.z = pk_bf16(C[2 * kk + 1][0], C[2 * kk + 1][1]); bc.w = pk_bf16(C[2 * kk + 1][2], C[2 * kk + 1][3]);
                const bf16x8 cfrag = __builtin_bit_cast(bf16x8, bc);
                SB();
#pragma unroll
                for (int mt = 0; mt < 4; ++mt) num[mt] = mfma16(cfrag, qf[kk & 1][mt], num[mt]);
                if (qdw) qacc = mfma16(nf[kk & 1], pf[kk & 1], qacc);
                SB();
            }
#undef QLOAD
            if (qdw && fq == 0) QD[16 * wid + fr] = qacc[0];
        }
        if (c > 0) SCAN_OUT(c - 1);
        lds_bar();
        const float mprev = MP[c];
        const float alast = AL[gi + L - 1];
        const float decay = __expf(alast + mprev);
        bf16x8 vb[2], vw[2], wn[2], swa[6];
        {
            s16x4 v0[2], v1[2]; f32x4 g0[2], g1[2]; float sc[4];
#pragma unroll
            for (int kk = 0; kk < 2; ++kk) {
                const LAS unsigned char* base = lds + L_V + (32 * kk + 4 * fq + (fr >> 2)) * VST + (e0 + 4 * (fr & 3)) * 2;
                v0[kk] = tr_read(base); v1[kk] = tr_read(base + 16 * VST);
                g0[kk] = *(const LAS f32x4*)(GG + gi + 32 * kk + 4 * fq); g1[kk] = *(const LAS f32x4*)(GG + gi + 32 * kk + 16 + 4 * fq);
            }
#pragma unroll
            for (int mt = 0; mt < 4; ++mt) sc[mt] = AL[gi + 16 * mt + fr];
#define SWF(row, k0) cat8(*(const LAS s16x4*)(lds + L_SW + ((row) + fr) * SST + ((k0) + 4 * fq) * 2), *(const LAS s16x4*)(lds + L_SW + ((row) + fr) * SST + ((k0) + 16 + 4 * fq) * 2))
            swa[0] = SWF(0, 0); swa[1] = SWF(16, 0); swa[2] = SWF(32, 0); swa[3] = SWF(32, 32); swa[4] = SWF(48, 0); swa[5] = SWF(48, 32);
#undef SWF
            SB();
#pragma unroll
            for (int mt = 0; mt < 4; ++mt) { const float e = __expf(sc[mt] + mprev);
#pragma unroll
                for (int j = 0; j < 4; ++j) num[mt][j] *= e; }
#pragma unroll
            for (int kk = 0; kk < 2; ++kk) {
                vb[kk] = cat8(v0[kk], v1[kk]);
                float f[8], we[8];
#pragma unroll
                for (int j = 0; j < 4; ++j) { we[j] = __expf(alast + g0[kk][j]); we[4 + j] = __expf(alast + g1[kk][j]); f[j] = bf2f(vb[kk][j]) * we[j]; f[4 + j] = bf2f(vb[kk][4 + j]) * we[4 + j]; }
                u32x4 o; o.x = pk_bf16(f[0], f[1]); o.y = pk_bf16(f[2], f[3]); o.z = pk_bf16(f[4], f[5]); o.w = pk_bf16(f[6], f[7]);
                vw[kk] = __builtin_bit_cast(bf16x8, o);
                u32x4 wo; wo.x = pk_bf16(we[0], we[1]); wo.y = pk_bf16(we[2], we[3]); wo.z = pk_bf16(we[4], we[5]); wo.w = pk_bf16(we[6], we[7]);
                if (fr != 0) { wo.x = 0u; wo.y = 0u; wo.z = 0u; wo.w = 0u; }
                wn[kk] = __builtin_bit_cast(bf16x8, wo);
            }
        }
        {
            const int t = wid * 8 + (lane >> 3), part = lane & 7;
            const bf16x8 v = *(const LAS bf16x8*)(lds + L_SW + t * SST + part * 16);
            float rs = 0.f;
#pragma unroll
            for (int j = 0; j < 8; ++j) rs += bf2f(v[j]);
            rs += __shfl_xor(rs, 1); rs += __shfl_xor(rs, 2); rs += __shfl_xor(rs, 4);
            if (part == 0) { const float inter = __expf(AL[gi + t] + mprev);
                DEN[t] = __fdividef(1.f, fmaxf(fabsf(inter * QD[t] + rs), __expf(-MM[gi + t]))); }
        }
        num[0] = mfma16(vb[0], swa[0], num[0]); num[1] = mfma16(vb[0], swa[1], num[1]);
        num[2] = mfma16(vb[0], swa[2], num[2]); num[2] = mfma16(vb[1], swa[3], num[2]);
        num[3] = mfma16(vb[0], swa[4], num[3]); num[3] = mfma16(vb[1], swa[5], num[3]);
#pragma unroll
        for (int mt = 0; mt < 4; ++mt) { u32x2 o; o.x = pk_bf16(num[mt][0], num[mt][1]); o.y = pk_bf16(num[mt][2], num[mt][3]);
            *(LAS u32x2*)(lds + L_OUT + (16 * mt + fr) * VST + (e0 + 4 * fq) * 2) = o; }
        {
            s16x4 ka[2][8];
            const LAS unsigned char* kb0 = lds + L_K + (4 * fq + (fr >> 2)) * KST + (4 * (fr & 3)) * 2;
#define KLOAD(buf, ii) do { _Pragma("unroll") for (int h_ = 0; h_ < 2; ++h_) { ka[buf][4 * h_ + 0] = tr_read(kb0 + ((ii) + h_) * 32); ka[buf][4 * h_ + 1] = tr_read(kb0 + ((ii) + h_) * 32 + 16 * KST); \
                ka[buf][4 * h_ + 2] = tr_read(kb0 + ((ii) + h_) * 32 + 32 * KST); ka[buf][4 * h_ + 3] = tr_read(kb0 + ((ii) + h_) * 32 + 48 * KST); } } while (0)
            f32x4 nacc[2] = {{0.f, 0.f, 0.f, 0.f}, {0.f, 0.f, 0.f, 0.f}};
            KLOAD(0, 0);
#pragma unroll
            for (int ip = 0; ip < 8; ++ip) {
                const int i = 2 * ip;
                if (ip < 7) KLOAD((ip + 1) & 1, i + 2);
                C[i] *= decay; C[i + 1] *= decay;
                SB();
                C[i] = mfma16(cat8(ka[ip & 1][0], ka[ip & 1][1]), vw[0], C[i]);
                C[i + 1] = mfma16(cat8(ka[ip & 1][4], ka[ip & 1][5]), vw[0], C[i + 1]);
                C[i] = mfma16(cat8(ka[ip & 1][2], ka[ip & 1][3]), vw[1], C[i]);
                C[i + 1] = mfma16(cat8(ka[ip & 1][6], ka[ip & 1][7]), vw[1], C[i + 1]);
                if (ip == wid) {
                    nacc[0] = mfma16(cat8(ka[ip & 1][0], ka[ip & 1][1]), wn[0], nacc[0]); nacc[1] = mfma16(cat8(ka[ip & 1][4], ka[ip & 1][5]), wn[0], nacc[1]);
                    nacc[0] = mfma16(cat8(ka[ip & 1][2], ka[ip & 1][3]), wn[1], nacc[0]); nacc[1] = mfma16(cat8(ka[ip & 1][6], ka[ip & 1][7]), wn[1], nacc[1]);
                }
                SB();
            }
#undef KLOAD
            if (fr == 0) {
#pragma unroll
                for (int ii = 0; ii < 2; ++ii) { LAS f32x4* np = (LAS f32x4*)(NV + 32 * wid + 16 * ii + 4 * fq); const f32x4 o = *np * decay + nacc[ii]; *np = o;
                    u32x2 ob; ob.x = pk_bf16(o[0], o[1]); ob.y = pk_bf16(o[2], o[3]); *(LAS u32x2*)(lds + L_NB + (32 * wid + 8 * fq + 4 * ii) * 2) = ob; }
            }
        }
#undef SB
        lds_bar();
    }
    SCAN_OUT(nch - 1);
#undef SCAN_ISSUE
#undef SCAN_OUT
    float* Cout = p.out + O_CP + (((size_t)b * 4 + h) * 256) * 256 + eh * 128 + e0;
    const unsigned cl_off = (unsigned)(4 * fq * 256 + fr);
#pragma unroll
    for (int i = 0; i < 16; ++i)
#pragma unroll
        for (int j = 0; j < 4; ++j) __builtin_nontemporal_store(C[i][j], &(Cout + (size_t)i * 4096)[cl_off + j * 256]);
    if (eh == 0) {
        if (tid < 256) (p.out + O_NP)[((size_t)b * 4 + h) * 256 + tid] = NV[tid];
        if (tid == 0) (p.out + O_MP)[b * 4 + h] = MP[nch];
    }
    __syncthreads();
}

constexpr int SWR = 10240, SW_K = 0, SW_Q = 4224, SW_V = 8448, SW_F = 8832;
DI void sample_wave_unit(const Params& p, const int item, LAS unsigned char* wl) {
    int lane = threadIdx.x & 63; asm volatile("" : "+v"(lane));
    const int fr = lane & 15, fq = lane >> 4, rr = fr & 7;
    const int es = item & 15, h = (item >> 4) & 3, b = item >> 6, bh = b * 4 + h, e0 = 16 * es, rowbase = ROWS_P + b * 8;
    const float* GATES = (const float*)(p.ws + W_GATES);
    const bf16_t* Qg = (const bf16_t*)(p.ws + W_Q); const bf16_t* Kg = (const bf16_t*)(p.ws + W_K); const bf16_t* Vg = (const bf16_t*)(p.ws + W_V);
    bf16_t* HT = (bf16_t*)(p.ws + W_HT);
    LAS float* AL = (LAS float*)(wl + SW_F); LAS float* GG = AL + 8; LAS float* MM = AL + 16;
    f32x4 C[16];
    const unsigned cl_off = (unsigned)(4 * fq * 256 + fr);
    { const float* Cs = p.state_C + ((size_t)bh * 256) * 256 + e0;
#pragma unroll
      for (int i = 0; i < 16; ++i)
#pragma unroll
          for (int j = 0; j < 4; ++j) C[i][j] = (Cs + (size_t)i * 4096)[cl_off + j * 256]; }
    { const int r = lane >> 3, seg = lane & 7; const size_t grow = (size_t)(rowbase + r) * 1024 + h * 256;
#pragma unroll
      for (int i = 0; i < 4; ++i) { const int c16 = seg + 8 * i;
          *(LAS u32x4*)(wl + SW_K + r * QST + c16 * 16) = *(const u32x4*)(Kg + grow + c16 * 8);
          *(LAS u32x4*)(wl + SW_Q + r * QST + c16 * 16) = *(const u32x4*)(Qg + grow + c16 * 8); }
      if (lane < 16) { const int vr = lane >> 1, hf = lane & 1; *(LAS u32x4*)(wl + SW_V + vr * 48 + hf * 16) = *(const u32x4*)(Vg + (size_t)(rowbase + vr) * 1024 + h * 256 + e0 + hf * 8); } }
    const float mprev = p.state_m[bh];
    {
        const int t = lane & 7; const float* g = GATES + (size_t)(rowbase + t) * 8; const float ig = g[h]; float bs = g[4 + h];
#pragma unroll
        for (int o = 1; o < 8; o <<= 1) { const float v = __shfl_up(bs, o, 8); if (t >= o) bs += v; }
        const float gg = ig - bs; float P = gg;
#pragma unroll
        for (int o = 1; o < 8; o <<= 1) { const float v = __shfl_up(P, o, 8); if (t >= o) P = fmaxf(P, v); }
        const float mt = bs + fmaxf(mprev, P);
        if (lane < 8) { AL[t] = bs - mt; GG[t] = gg; MM[t] = mt; }
    }
    asm volatile("" ::: "memory");
    const float alast = AL[7], decay = __expf(alast + mprev), al_t = AL[rr];
    const f32x4 g4 = *(const LAS f32x4*)(GG + 4 * (fq & 1));
    f32x4 a = {0.f, 0.f, 0.f, 0.f};
#pragma unroll
    for (int kk = 0; kk < 8; ++kk) {
        const bf16x8 ak = *(const LAS bf16x8*)(wl + SW_K + rr * QST + (kk * 32 + fq * 8) * 2);
        const bf16x8 bq = *(const LAS bf16x8*)(wl + SW_Q + rr * QST + (kk * 32 + fq * 8) * 2);
        a = mfma16(ak, bq, a);
    }
    float w[4], rs = 0.f;
#pragma unroll
    for (int j = 0; j < 4; ++j) { const int sx = 4 * fq + j; w[j] = (fq < 2 && fr < 8 && sx <= fr) ? a[j] * __expf(al_t + g4[j]) : 0.f; rs += w[j]; }
    rs += __shfl_xor(rs, 16); rs += __shfl_xor(rs, 32);
    u32x4 swu; swu.x = pk_bf16(w[0], w[1]); swu.y = pk_bf16(w[2], w[3]); swu.z = 0u; swu.w = 0u;
    const bf16x8 swf = __builtin_bit_cast(bf16x8, swu);
    float qd = 0.f;
    {   const int part = lane >> 3; const float* nv = p.state_n + (size_t)bh * 256 + 32 * part;
#pragma unroll
        for (int i = 0; i < 4; ++i) { const bf16x8 q = *(const LAS bf16x8*)(wl + SW_Q + (lane & 7) * QST + (part * 4 + i) * 16);
            const float4 n0 = *(const float4*)(nv + 8 * i), n1 = *(const float4*)(nv + 8 * i + 4);
            qd += bf2f(q[0]) * n0.x + bf2f(q[1]) * n0.y + bf2f(q[2]) * n0.z + bf2f(q[3]) * n0.w + bf2f(q[4]) * n1.x + bf2f(q[5]) * n1.y + bf2f(q[6]) * n1.z + bf2f(q[7]) * n1.w; }
        qd += __shfl_xor(qd, 8); qd += __shfl_xor(qd, 16); qd += __shfl_xor(qd, 32); }
    const float inter = __expf(al_t + mprev);
    const float dn = __fdividef(1.f, fmaxf(fabsf(inter * qd + rs), __expf(-MM[rr])));
    f32x4 num = {0.f, 0.f, 0.f, 0.f};
#pragma unroll
    for (int kk = 0; kk < 8; ++kk) {
        u32x4 bc; bc.x = pk_bf16(C[2 * kk][0], C[2 * kk][1]); bc.y = pk_bf16(C[2 * kk][2], C[2 * kk][3]); bc.z = pk_bf16(C[2 * kk + 1][0], C[2 * kk + 1][1]); bc.w = pk_bf16(C[2 * kk + 1][2], C[2 * kk + 1][3]);
        const s16x4 lo = *(const LAS s16x4*)(wl + SW_Q + rr * QST + (32 * kk + 4 * fq) * 2);
        const s16x4 hi = *(const LAS s16x4*)(wl + SW_Q + rr * QST + (32 * kk + 16 + 4 * fq) * 2);
        num = mfma16(__builtin_bit_cast(bf16x8, bc), cat8(lo, hi), num);
    }
#pragma unroll
    for (int j = 0; j < 4; ++j) num[j] *= inter;
    const s16x4 zero4 = {0, 0, 0, 0};
    const s16x4 v4 = tr_read(wl + SW_V + (4 * (fq & 1) + (fr >> 2)) * 48 + (4 * (fr & 3)) * 2);
    num = mfma16(cat8(v4, zero4), swf, num);
    if (fr < 8) { u32x2 o; o.x = pk_bf16(num[0] * dn, num[1] * dn); o.y = pk_bf16(num[2] * dn, num[3] * dn);
        *(u32x2*)(HT + (size_t)(rowbase + fr) * 1024 + h * 256 + e0 + 4 * fq) = o; }
    u32x4 vwu; { float f[4];
#pragma unroll
        for (int j = 0; j < 4; ++j) f[j] = fq < 2 ? bf2f(v4[j]) * __expf(alast + g4[j]) : 0.f;
        vwu.x = pk_bf16(f[0], f[1]); vwu.y = pk_bf16(f[2], f[3]); vwu.z = 0u; vwu.w = 0u; }
    const bf16x8 vwf = __builtin_bit_cast(bf16x8, vwu);
    float* Cout = p.out + O_CS + ((size_t)bh * 256) * 256 + e0;
#pragma unroll
    for (int i = 0; i < 16; ++i) {
        const s16x4 k4 = tr_read(wl + SW_K + (4 * (fq & 1) + (fr >> 2)) * QST + (16 * i + 4 * (fr & 3)) * 2);
        C[i] = mfma16(cat8(k4, zero4), vwf, C[i] * decay);
#pragma unroll
        for (int j = 0; j < 4; ++j) __builtin_nontemporal_store(C[i][j], &(Cout + (size_t)i * 4096)[cl_off + j * 256]);
    }
    if (es == 0) {
        const float4 nn = *(const float4*)(p.state_n + (size_t)bh * 256 + 4 * lane);
        float n0 = decay * nn.x, n1 = decay * nn.y, n2 = decay * nn.z, n3 = decay * nn.w;
#pragma unroll
        for (int sx = 0; sx < 8; ++sx) { const float ws = __expf(alast + GG[sx]); const u32x2 kk = *(const LAS u32x2*)(wl + SW_K + sx * QST + lane * 8);
            n0 += ws * bf_lo(kk.x); n1 += ws * bf_hi(kk.x); n2 += ws * bf_lo(kk.y); n3 += ws * bf_hi(kk.y); }
        float4 o4; o4.x = n0; o4.y = n1; o4.z = n2; o4.w = n3;
        *(float4*)(p.out + O_NS + (size_t)bh * 256 + 4 * lane) = o4;
        if (lane == 0) (p.out + O_MS)[bh] = MM[7];
    }
    asm volatile("" ::: "memory");
}

DI void pool_unit(const Params& p, const int tile, const int g, LAS unsigned char* lds) {
    const int tid = opaque_tid(), lane = tid & 63, wid = __builtin_amdgcn_readfirstlane(tid >> 6), fr = lane & 15, fq = lane >> 4;
    const int w = 2 << g;
    const bf16_t* U = (const bf16_t*)(p.ws + W_U); const bf16_t* ZA = (const bf16_t*)(p.ws + W_ZA); bf16_t* Y = (bf16_t*)(p.ws + W_Y);
    bf16x8 bw[8][2];
    { const bf16_t* Wp = (const bf16_t*)(p.ws + W_WPOOL) + (size_t)g * 65536;
#pragma unroll
      for (int kk = 0; kk < 8; ++kk)
#pragma unroll
          for (int n = 0; n < 2; ++n) bw[kk][n] = *(const bf16x8*)(Wp + (size_t)(32 * wid + 16 * n + fr) * 256 + 32 * kk + 8 * fq); }
    __syncthreads();
    if (tile < ROWS_P / 64) {
        constexpr int L_US = L_K;
        const int R0 = tile * 64;
        for (int q = tid; q < 79 * 32; q += 512) { const int i = q >> 5, c16 = q & 31; int gr = R0 - 15 + i; gr = gr < 0 ? 0 : gr;
            *(LAS u32x4*)(lds + L_US + i * QST + c16 * 16) = *(const u32x4*)(U + (size_t)gr * 1024 + 256 * g + c16 * 8); }
        __syncthreads();
        for (int it = 0; it < 4; ++it) {
            const int item = tid + 512 * it, r = item >> 5, cg8 = item & 31;
            const int row = R0 + r, b = row / TPR, t = row - b * TPR, cnt = min(w, t + 1);
            float s[8], cur[8];
#pragma unroll
            for (int i = 0; i < 8; ++i) { s[i] = 0.f; cur[i] = 0.f; }
            for (int j = 0; j < cnt; ++j) {
                const u32x4 v = *(const LAS u32x4*)(lds + L_US + (r + 15 - j) * QST + cg8 * 16);
                const float f0 = bf_lo(v.x), f1 = bf_hi(v.x), f2 = bf_lo(v.y), f3 = bf_hi(v.y), f4 = bf_lo(v.z), f5 = bf_hi(v.z), f6 = bf_lo(v.w), f7 = bf_hi(v.w);
                s[0] += f0; s[1] += f1; s[2] += f2; s[3] += f3; s[4] += f4; s[5] += f5; s[6] += f6; s[7] += f7;
                if (j == 0) { cur[0] = f0; cur[1] = f1; cur[2] = f2; cur[3] = f3; cur[4] = f4; cur[5] = f5; cur[6] = f6; cur[7] = f7; }
            }
            const float inv = 1.f / (float)cnt;
            u32x4 o; o.x = pk_bf16(s[0] * inv - cur[0], s[1] * inv - cur[1]); o.y = pk_bf16(s[2] * inv - cur[2], s[3] * inv - cur[3]);
            o.z = pk_bf16(s[4] * inv - cur[4], s[5] * inv - cur[5]); o.w = pk_bf16(s[6] * inv - cur[6], s[7] * inv - cur[7]);
            *(LAS u32x4*)(lds + L_Q + r * QST + cg8 * 16) = o;
        }
    } else
    for (int it = 0; it < 4; ++it) {
        const int item = tid + 512 * it, r = item >> 5, cg8 = item & 31;
        const int row = tile * 64 + r, ch = 256 * g + 8 * cg8;
        const bool sample = row >= ROWS_P;
        int b, t, cnt;
        if (!sample) { b = row / TPR; t = row - b * TPR; cnt = min(w, t + 1); } else { const int si = row - ROWS_P; b = si >> 3; t = si & 7; cnt = w; }
        float s[8], cur[8];
#pragma unroll
        for (int i = 0; i < 8; ++i) { s[i] = 0.f; cur[i] = 0.f; }
        for (int j = 0; j < w; ++j) {
            if (j <= t) {
                const u32x4 v = *(const u32x4*)(U + (size_t)(row - j) * 1024 + ch);
                const float f0 = bf_lo(v.x), f1 = bf_hi(v.x), f2 = bf_lo(v.y), f3 = bf_hi(v.y), f4 = bf_lo(v.z), f5 = bf_hi(v.z), f6 = bf_lo(v.w), f7 = bf_hi(v.w);
                s[0] += f0; s[1] += f1; s[2] += f2; s[3] += f3; s[4] += f4; s[5] += f5; s[6] += f6; s[7] += f7;
                if (j == 0) { cur[0] = f0; cur[1] = f1; cur[2] = f2; cur[3] = f3; cur[4] = f4; cur[5] = f5; cur[6] = f6; cur[7] = f7; }
            } else if (sample) {
                const float* sp = p.state_pool + ((size_t)b * 15 + (15 + t - j)) * 1024 + ch;
                const float4 a = *(const float4*)sp, c4 = *(const float4*)(sp + 4);
                s[0] += a.x; s[1] += a.y; s[2] += a.z; s[3] += a.w; s[4] += c4.x; s[5] += c4.y; s[6] += c4.z; s[7] += c4.w;
            }
        }
        const float inv = 1.f / (float)cnt;
        u32x4 o; o.x = pk_bf16(s[0] * inv - cur[0], s[1] * inv - cur[1]); o.y = pk_bf16(s[2] * inv - cur[2], s[3] * inv - cur[3]);
        o.z = pk_bf16(s[4] * inv - cur[4], s[5] * inv - cur[5]); o.w = pk_bf16(s[6] * inv - cur[6], s[7] * inv - cur[7]);
        *(LAS u32x4*)(lds + L_Q + r * QST + cg8 * 16) = o;
    }
    __syncthreads();
    f32x4 acc[4][2];
#pragma unroll
    for (int mt = 0; mt < 4; ++mt) { acc[mt][0] = (f32x4){0.f, 0.f, 0.f, 0.f}; acc[mt][1] = (f32x4){0.f, 0.f, 0.f, 0.f}; }
    {
        bf16x8 af[2][4];
#pragma unroll
        for (int mt = 0; mt < 4; ++mt) af[0][mt] = *(const LAS bf16x8*)(lds + L_Q + (16 * mt + fr) * QST + (8 * fq) * 2);
#pragma unroll
        for (int kk = 0; kk < 8; ++kk) {
            if (kk < 7) {
#pragma unroll
                for (int mt = 0; mt < 4; ++mt) af[(kk + 1) & 1][mt] = *(const LAS bf16x8*)(lds + L_Q + (16 * mt + fr) * QST + (32 * (kk + 1) + 8 * fq) * 2);
            }
            __builtin_amdgcn_sched_barrier(0);
#pragma unroll
            for (int mt = 0; mt < 4; ++mt)
#pragma unroll
                for (int n = 0; n < 2; ++n) acc[mt][n] = mfma16(bw[kk][n], af[kk & 1][mt], acc[mt][n]);
            __builtin_amdgcn_sched_barrier(0);
        }
    }
#pragma unroll
    for (int mt = 0; mt < 4; ++mt) {
        const int row = tile * 64 + 16 * mt + fr;
#pragma unroll
        for (int n = 0; n < 2; ++n) {
            const int d = 256 * g + 32 * wid + 16 * n + 4 * fq;
            const u32x2 za = *(const u32x2*)(ZA + (size_t)row * 1024 + d);
            u32x2 o; o.x = pk_bf16(acc[mt][n][0] * bf_lo(za.x), acc[mt][n][1] * bf_hi(za.x)); o.y = pk_bf16(acc[mt][n][2] * bf_lo(za.y), acc[mt][n][3] * bf_hi(za.y));
            *(u32x2*)(Y + (size_t)row * 2048 + d) = o;
        }
    }
}

constexpr int N_ITEMS2 = 8192;
DI void gemm1_run(const Params& p, LAS unsigned char* lds, int G, int c, int first, int last) {
    pg8::Gemm g; g.A = (const bf16_t*)(p.ws + W_XN); g.Bt = (const bf16_t*)(p.ws + W_WIN); g.M = TP; g.N = 7168; g.K = 1024;
    SegOrder S; S.G = G; S.c = c; S.first = first; S.last = last;
    EpiG1 E; E.U = (bf16_t*)(p.ws + W_U); E.ZA = (bf16_t*)(p.ws + W_ZA); E.Q = (bf16_t*)(p.ws + W_Q); E.K = (bf16_t*)(p.ws + W_K); E.V = (bf16_t*)(p.ws + W_V); E.G = (bf16_t*)(p.ws + W_G); E.pool_scale = p.pool_scale;
    pg8::gemm_phase<EpiG1, SegOrder, false>(lds, g, S, E, nullptr);
}
constexpr int G1_SPLIT = 1536, N_SCAN_WG = 64;
DI void phase2(const Params& p, LAS unsigned char* lds, int rep) {
    if ((int)blockIdx.x < N_SCAN_WG) {
        for (int rr = 0; rr < ((PROBE_DUP & 64) ? 2 : 1); ++rr)
        for (int u = blockIdx.x; u < 64; u += N_SCAN_WG) { const int eh = (u >> 3) & 1, bh = (u & 7) + 8 * (u >> 4); scan_unit(p, bh >> 2, bh & 3, eh, lds); }
    } else {
        gemm1_run(p, lds, (int)gridDim.x - N_SCAN_WG, (int)blockIdx.x - N_SCAN_WG, G1_SPLIT, 1932);
        __syncthreads();
        for (int i = (int)blockIdx.x - N_SCAN_WG; i < NU0_WOUT; i += (int)gridDim.x - N_SCAN_WG) { const int pn = i >> 5, kb = i & 31;
            p0_transpose(p.w_out, 1024, 256 * pn, 256 * pn + 128, false, 1.f, (bf16_t*)(p.ws + W_WOUT) + (size_t)pn * 256 * 2048, 2048, 64 * kb, lds); }
    }
    __syncthreads();
    {
        unsigned* pctr = (unsigned*)(p.ws + W_CTR) + 8 + rep;
        for (;;) {
            __syncthreads();
            if (threadIdx.x == 0) *(LAS int*)(lds + L_CTL) = (int)atomicAdd(pctr, 1u);
            __syncthreads();
            const int pt = *(const LAS int*)(lds + L_CTL);
            if (pt >= 1096) break;
            pool_unit(p, pt >> 2, pt & 3, lds);
        }
        __syncthreads();
    }
    const int wv = __builtin_amdgcn_readfirstlane((int)(threadIdx.x >> 6));
    for (int qq = 0; qq < ((PROBE_DUP & 128) ? 2 : 1); ++qq) {
    unsigned* ctr = (unsigned*)(p.ws + W_CTR) + rep + 2 * qq;
    for (;;) {
        int item = 0;
        if ((threadIdx.x & 63) == 0) item = (int)atomicAdd(ctr, 1u);
        item = __builtin_amdgcn_readfirstlane(item);
        if (item >= N_ITEMS2) break;
        sample_wave_unit(p, item, lds + wv * SWR);
    }
    }
}

DI void ln_finish(const Params& p, int r, int lane, const u32x4 h0, const u32x4 h1, const u32x4 g0, const u32x4 g1) {
    bf16_t* Y = (bf16_t*)(p.ws + W_Y);
    const int ch = 16 * lane;
    float v[16] = {bf_lo(h0.x), bf_hi(h0.x), bf_lo(h0.y), bf_hi(h0.y), bf_lo(h0.z), bf_hi(h0.z), bf_lo(h0.w), bf_hi(h0.w),
                   bf_lo(h1.x), bf_hi(h1.x), bf_lo(h1.y), bf_hi(h1.y), bf_lo(h1.z), bf_hi(h1.z), bf_lo(h1.w), bf_hi(h1.w)};
    float s = 0.f;
#pragma unroll
    for (int i = 0; i < 16; ++i) s += v[i];
    s += __shfl_xor(s, 1); s += __shfl_xor(s, 2); s += __shfl_xor(s, 4); s += __shfl_xor(s, 8);
    const float mu = s * (1.f / 256.f);
    float q = 0.f;
#pragma unroll
    for (int i = 0; i < 16; ++i) { v[i] -= mu; q += v[i] * v[i]; }
    q += __shfl_xor(q, 1); q += __shfl_xor(q, 2); q += __shfl_xor(q, 4); q += __shfl_xor(q, 8);
    const float rstd = rsqrtf(q * (1.f / 256.f) + 1e-6f);
    const float gg[16] = {bf_lo(g0.x), bf_hi(g0.x), bf_lo(g0.y), bf_hi(g0.y), bf_lo(g0.z), bf_hi(g0.z), bf_lo(g0.w), bf_hi(g0.w),
                          bf_lo(g1.x), bf_hi(g1.x), bf_lo(g1.y), bf_hi(g1.y), bf_lo(g1.z), bf_hi(g1.z), bf_lo(g1.w), bf_hi(g1.w)};
    float o[16];
#pragma unroll
    for (int i = 0; i < 4; ++i) { const float4 w4 = *(const float4*)(p.mhln_w + ch + 4 * i);
        o[4 * i] = v[4 * i] * rstd * w4.x * gg[4 * i]; o[4 * i + 1] = v[4 * i + 1] * rstd * w4.y * gg[4 * i + 1];
        o[4 * i + 2] = v[4 * i + 2] * rstd * w4.z * gg[4 * i + 2]; o[4 * i + 3] = v[4 * i + 3] * rstd * w4.w * gg[4 * i + 3]; }
    u32x4 a, c;
    a.x = pk_bf16(o[0], o[1]); a.y = pk_bf16(o[2], o[3]); a.z = pk_bf16(o[4], o[5]); a.w = pk_bf16(o[6], o[7]);
    c.x = pk_bf16(o[8], o[9]); c.y = pk_bf16(o[10], o[11]); c.z = pk_bf16(o[12], o[13]); c.w = pk_bf16(o[14], o[15]);
    *(u32x4*)(Y + (size_t)r * 2048 + 1024 + ch) = a; *(u32x4*)(Y + (size_t)r * 2048 + 1024 + ch + 8) = c;
}
DI void phase3(const Params& p, LAS unsigned char* lds) {
    (void)lds;
    const int tid = opaque_tid(), lane = tid & 63, wid = __builtin_amdgcn_readfirstlane(tid >> 6);
    const bf16_t* HT = (const bf16_t*)(p.ws + W_HT); const bf16_t* G = (const bf16_t*)(p.ws + W_G); const bf16_t* U = (const bf16_t*)(p.ws + W_U);
    const int stride = gridDim.x * 8, ch = 16 * lane;
    for (int r = blockIdx.x * 8 + wid; r < T; r += 2 * stride) {
        const int r2 = r + stride < T ? r + stride : r;
        const u32x4 h0 = *(const u32x4*)(HT + (size_t)r * 1024 + ch), h1 = *(const u32x4*)(HT + (size_t)r * 1024 + ch + 8);
        const u32x4 g0 = *(const u32x4*)(G + (size_t)r * 1024 + ch), g1 = *(const u32x4*)(G + (size_t)r * 1024 + ch + 8);
        const u32x4 h2 = *(const u32x4*)(HT + (size_t)r2 * 1024 + ch), h3 = *(const u32x4*)(HT + (size_t)r2 * 1024 + ch + 8);
        const u32x4 g2 = *(const u32x4*)(G + (size_t)r2 * 1024 + ch), g3 = *(const u32x4*)(G + (size_t)r2 * 1024 + ch + 8);
        ln_finish(p, r, lane, h0, h1, g0, g1);
        if (r2 != r) ln_finish(p, r2, lane, h2, h3, g2, g3);
    }
    for (int i = blockIdx.x * 512 + tid; i < 16384; i += gridDim.x * 512) ((float*)(p.ws + W_RSS))[i] = 0.f;
    const int gtid = (int)blockIdx.x * 512 + tid, gstr = (int)gridDim.x * 512;
    for (int i = gtid; i < 122880 / 4; i += gstr) { const int c = (i & 255) * 4, ri = i >> 8, b = ri / 15, k = ri - b * 15;
        const u32x2 v = *(const u32x2*)(U + (size_t)(b * TPR + 2049 + k) * 1024 + c);
        f32x4 o; o[0] = bf_lo(v.x); o[1] = bf_hi(v.x); o[2] = bf_lo(v.y); o[3] = bf_hi(v.y);
        __builtin_nontemporal_store(o, (f32x4*)(p.out + O_PP + (size_t)i * 4)); }
    for (int i = gtid; i < 1966080 / 4; i += gstr) { const int c = (i & 255) * 4, ri = i >> 8, b = ri / 15, k = ri - b * 15;
        f32x4 o;
        if (k < 7) o = __builtin_nontemporal_load((const f32x4*)(p.state_pool + ((size_t)b * 15 + 8 + k) * 1024 + c));
        else { const u32x2 v = *(const u32x2*)(U + (size_t)(ROWS_P + b * 8 + k - 7) * 1024 + c); o[0] = bf_lo(v.x); o[1] = bf_hi(v.x); o[2] = bf_lo(v.y); o[3] = bf_hi(v.y); }
        __builtin_nontemporal_store(o, (f32x4*)(p.out + O_PS + (size_t)i * 4)); }
}

DI void p5_load(const Params& p, int o, int lane, float4 (&v)[4]) {
    const int R = o < 16384 ? (o >> 11) * TPR + (o & 2047) + NMETA : ROWS_P + (o - 16384);
    if (R >= 16384) {
        const float* xr = o < 16384 ? p.x_prompt + (size_t)o * 1024 : p.x_sample + (size_t)(o - 16384) * 1024;
        const float* pp = (const float*)(p.ws + W_Q) + (size_t)(R - 16384) * 1024;
#pragma unroll
        for (int j = 0; j < 4; ++j) { v[j] = *(const float4*)(xr + 4 * lane + 256 * j);
#pragma unroll
            for (int ks = 0; ks < 8; ++ks) { const float4 q = *(const float4*)(pp + (size_t)ks * 1280 * 1024 + 4 * lane + 256 * j); v[j].x += q.x; v[j].y += q.y; v[j].z += q.z; v[j].w += q.w; } }
    } else {
        const float* row = p.out + (size_t)o * 1024;
#pragma unroll
        for (int j = 0; j < 4; ++j) v[j] = *(const float4*)(row + 4 * lane + 256 * j);
    }
}
DI void p5_finish(const Params& p, int o, int lane, float4 (&v)[4]) {
    float ss = 0.f;
#pragma unroll
    for (int j = 0; j < 4; ++j) ss += v[j].x * v[j].x + v[j].y * v[j].y + v[j].z * v[j].z + v[j].w * v[j].w;
    ss = wave_sum(ss);
    const float rstd = rsqrtf(ss * (1.f / 1024.f) + 1e-6f);
    float* row = p.out + (size_t)o * 1024;
#pragma unroll
    for (int j = 0; j < 4; ++j) { const float4 w = *(const float4*)(p.normf_w + 4 * lane + 256 * j);
        f32x4 o_; o_[0] = v[j].x * rstd * w.x; o_[1] = v[j].y * rstd * w.y; o_[2] = v[j].z * rstd * w.z; o_[3] = v[j].w * rstd * w.w; __builtin_nontemporal_store(o_, (f32x4*)(row + 4 * lane + 256 * j)); }
}
DI void phase5(const Params& p) {
    const int tid = opaque_tid(), lane = tid & 63, wid = __builtin_amdgcn_readfirstlane(tid >> 6);
    const int N = 16384 + 1024, stride = gridDim.x * 8;
    for (int o = 16256 + blockIdx.x * 8 + wid; o < N; o += 2 * stride) {
        const int o2 = o + stride; const bool has2 = o2 < N;
        float4 va[4], vb[4];
        p5_load(p, o, lane, va);
        if (has2) p5_load(p, o2, lane, vb);
        p5_finish(p, o, lane, va);
        if (has2) p5_finish(p, o2, lane, vb);
    }
}

DI void run_phase(const Params& p, int ph, LAS unsigned char* lds, int rep = 0) {
    if (ph == 0) phase0(p, lds);
    else if (ph == 1) { gemm1_run(p, lds, (int)gridDim.x, (int)blockIdx.x, 0, G1_SPLIT);
    } else if (ph == 2) phase2(p, lds, rep);
    else if (ph == 3) phase3(p, lds);
    else if (ph == 4) {
        pg8::Gemm g; g.A = (const bf16_t*)(p.ws + W_Y); g.Bt = (const bf16_t*)(p.ws + W_WOUT); g.M = TP; g.N = 1024; g.K = 2048;
        G2Order S; S.G = (int)gridDim.x; S.c = (int)blockIdx.x;
        EpiG2 E; E.x_prompt = p.x_prompt; E.xs_delta = (long)(p.x_sample - p.x_prompt); E.out = p.out; E.part = (float*)(p.ws + W_Q); E.rss = (float*)(p.ws + W_RSS); E.pcnt = (unsigned*)(p.ws + W_BAR) + 3456; E.normf_w = p.normf_w;
        pg8::gemm_phase<EpiG2, G2Order, false>(lds, g, S, E, nullptr);
    } else phase5(p);
}

template <bool COOP, int PH> __global__ __launch_bounds__(512, 2) void hymba_mega(Params p) {
    extern __shared__ __attribute__((aligned(16))) unsigned char smem[];
    LAS unsigned char* lds = (LAS unsigned char*)smem;
    if constexpr (COOP) {
        cg::grid_group grid = cg::this_grid();
        if (p.phase_hi == 777) grid.sync();
        if (threadIdx.x == 0) { *(LAS unsigned*)(lds + L_XB) = 0u; *(LAS unsigned*)(lds + L_XB + 4) = 0u; }
        __syncthreads();
        const XcdBarrier xb = xcd_barrier_post((unsigned*)(p.ws + W_BAR), (volatile LAS unsigned*)(lds + L_XB));
#define GSYNC() xcd_barrier(xb)
#define RUNPH(k) do { run_phase(p, k, lds); if (PROBE_DUP & (1 << k)) { GSYNC(); run_phase(p, k, lds, 1); } } while (0)
        RUNPH(0); GSYNC(); RUNPH(1); GSYNC(); RUNPH(2); GSYNC(); RUNPH(3); GSYNC(); RUNPH(4); GSYNC();
        if (PROBE_DUP & 32) { run_phase(p, 4, lds, 1); GSYNC(); }
        if (PROBE_DUP & 256) { GSYNC(); GSYNC(); GSYNC(); GSYNC(); }
        run_phase(p, 5, lds);
    } else {
        run_phase(p, PH, lds);
    }
}

extern "C" void kernel_launch(void* const* d_in, const int* in_sizes, int n_in, void* d_out, int out_size, void* d_ws, size_t ws_size, hipStream_t stream) {
    (void)in_sizes; (void)n_in; (void)out_size; (void)ws_size;
    Params p{};
    p.x_prompt = (const float*)d_in[0]; p.x_sample = (const float*)d_in[1]; p.state_pool = (const float*)d_in[2]; p.state_C = (const float*)d_in[3];
    p.state_n = (const float*)d_in[4]; p.state_m = (const float*)d_in[5]; p.meta = (const float*)d_in[6]; p.norm1_w = (const float*)d_in[7];
    p.w_in = (const float*)d_in[8]; p.b_if = (const float*)d_in[9]; p.w_pool = (const float*)d_in[10]; p.pool_scale = (const float*)d_in[11];
    p.mhln_w = (const float*)d_in[12]; p.w_out = (const float*)d_in[13]; p.normf_w = (const float*)d_in[14];
    p.out = (float*)d_out; p.ws = (unsigned char*)d_ws;
    static int grid_blocks = 0;
    if (!grid_blocks) {
        int dev = 0, cus = 0, per_cu = 0;
        (void)hipGetDevice(&dev);
        (void)hipDeviceGetAttribute(&cus, hipDeviceAttributeMultiprocessorCount, dev);
#if MK_MULTI
        (void)hipFuncSetAttribute((const void*)hymba_mega<false, 0>, hipFuncAttributeMaxDynamicSharedMemorySize, LDS_BYTES);
        (void)hipFuncSetAttribute((const void*)hymba_mega<false, 1>, hipFuncAttributeMaxDynamicSharedMemorySize, LDS_BYTES);
        (void)hipFuncSetAttribute((const void*)hymba_mega<false, 2>, hipFuncAttributeMaxDynamicSharedMemorySize, LDS_BYTES);
        (void)hipFuncSetAttribute((const void*)hymba_mega<false, 3>, hipFuncAttributeMaxDynamicSharedMemorySize, LDS_BYTES);
        (void)hipFuncSetAttribute((const void*)hymba_mega<false, 4>, hipFuncAttributeMaxDynamicSharedMemorySize, LDS_BYTES);
        (void)hipFuncSetAttribute((const void*)hymba_mega<false, 5>, hipFuncAttributeMaxDynamicSharedMemorySize, LDS_BYTES);
        per_cu = 1;
#else
        (void)hipFuncSetAttribute((const void*)hymba_mega<true, 0>, hipFuncAttributeMaxDynamicSharedMemorySize, LDS_BYTES);
        (void)hipOccupancyMaxActiveBlocksPerMultiprocessor(&per_cu, hymba_mega<true, 0>, 512, LDS_BYTES);
#endif
        if (per_cu < 1) per_cu = 1;
        grid_blocks = cus * per_cu;
    }
#if MK_MULTI
    hipLaunchKernelGGL((hymba_mega<false, 0>), dim3(grid_blocks), dim3(512), LDS_BYTES, stream, p);
    hipLaunchKernelGGL((hymba_mega<false, 1>), dim3(grid_blocks), dim3(512), LDS_BYTES, stream, p);
    hipLaunchKernelGGL((hymba_mega<false, 2>), dim3(grid_blocks), dim3(512), LDS_BYTES, stream, p);
    hipLaunchKernelGGL((hymba_mega<false, 3>), dim3(grid_blocks), dim3(512), LDS_BYTES, stream, p);
    hipLaunchKernelGGL((hymba_mega<false, 4>), dim3(grid_blocks), dim3(512), LDS_BYTES, stream, p);
    hipLaunchKernelGGL((hymba_mega<false, 5>), dim3(grid_blocks), dim3(512), LDS_BYTES, stream, p);
#else
    p.phase_lo = 0; p.phase_hi = 5;
    (void)hipMemsetAsync((unsigned char*)d_ws + W_CTR, 0, 256 + 16384, stream);
    void* args[] = {&p};
    hipError_t e = hipLaunchCooperativeKernel((const void*)hymba_mega<true, 0>, dim3(grid_blocks), dim3(512), args, LDS_BYTES, stream);
    if (e != hipSuccess) fprintf(stderr, "cooperative launch failed: %s (grid %d)\n", hipGetErrorString(e), grid_blocks);
#endif
}
```

```cpp
#include <hip/hip_runtime.h>
#include <hip/hip_cooperative_groups.h>
#include <cstdio>
#ifndef PROBE_DUP
#define PROBE_DUP 0
#endif
#ifndef MK_MULTI
#define MK_MULTI 0
#endif
namespace pg8 {
#define PG8_LAS __attribute__((address_space(3)))
typedef unsigned short bf16_t;
typedef short bf16x8 __attribute__((ext_vector_type(8)));
typedef float f32x4 __attribute__((ext_vector_type(4)));
typedef unsigned u32x4 __attribute__((ext_vector_type(4)));
constexpr int BM = 256, BK = 64, HALF = 128, HTB = HALF * BK * 2  , STAGE_BYTES = 8 * HTB, NXCD = 8, WGM = 8;

__host__ __device__ __forceinline__ int lds_byte(int r, int c) { const int st = (r >> 4) * 2 + (c >> 5), rr = r & 15, cc = c & 31, ob = rr * 64 + cc * 2; return st * 1024 + (ob ^ (((ob >> 9) & 1) << 5)); }
__host__ __device__ __forceinline__ void stage_rc(int b, int& R, int& C) { const int st = b / 1024, sb = b % 1024, swz = sb ^ (((sb >> 9) & 1) << 5); R = (st >> 1) * 16 + swz / 64; C = (st & 1) * 32 + (swz % 64) / 2; }
__host__ __device__ __forceinline__ int perm32(int rho) { const int n = rho >> 4, i = rho & 15; return 8 * (i >> 2) + 4 * n + (i & 3); }

struct Unit { int pm, pn, koff, klen; };
struct Gemm { const bf16_t* A; const bf16_t* Bt; int M, N, K; };

struct StaticOrder {
    int nM, nN, nwg, G, c;
    __host__ __device__ void init(int M, int N, int G_, int c_) { nM = M / BM; nN = N / BM; nwg = nM * nN; G = G_; c = c_; }
    __host__ __device__ bool next(int i, Unit& u) const {
        const long L = (long)i * G + c; if (L >= nwg) return false;
        int wgid = (int)L; { const int q = nwg / NXCD, r = nwg % NXCD, xcd = wgid % NXCD, off = wgid / NXCD; wgid = (xcd < r ? xcd * (q + 1) : r * (q + 1) + (xcd - r) * q) + off; }
        const int nig = WGM * nN, gid = wgid / nig, fm = gid * WGM, gsz = (nM - fm) < WGM ? (nM - fm) : WGM;
        u.pm = fm + ((wgid % nig) % gsz); u.pn = (wgid % nig) / gsz; u.koff = 0; u.klen = 0; return true;
    }
    __device__ __forceinline__ void a_ready(const Unit&) const {}
    __device__ __forceinline__ void done(const Unit&) const {}
};

template <class Epi, class Sched, bool STAMP = false>
__device__ __forceinline__ void gemm_phase(PG8_LAS unsigned char* lds, const Gemm g, const Sched& S, const Epi& E, unsigned long long* stamps) {
    int tid_ = threadIdx.x; asm volatile("" : "+v"(tid_)); const int tid = tid_, wid = __builtin_amdgcn_readfirstlane(tid >> 6), lane = tid & 63, wr = wid >> 2, wc = wid & 3, fr = lane & 15, fq = lane >> 4;
    const int K = g.K, nt = K / BK;
    int ts_lo = 0, ts_hi = 0, nts = 0; const unsigned long long rt_entry = STAMP ? (unsigned long long)wall_clock64() : 0ull;
#define PG8_STAMP() do { if (STAMP && wid == 0 && nts < 64) { const unsigned long long _c = (unsigned long long)clock64(); \
        ts_lo = (lane == nts) ? (int)(unsigned)_c : ts_lo; ts_hi = (lane == nts) ? (int)(unsigned)(_c >> 32) : ts_hi; ++nts; } } while (0)
    PG8_STAMP();
    unsigned voffA[2], voffB[2];
#pragma unroll
    for (int i = 0; i < 2; ++i) { int R, C; stage_rc(tid * 16 + i * 8192, R, C); const int Rb = Epi::PERM ? ((R & ~31) + perm32(R & 31)) : R;
        voffA[i] = (unsigned)(R * K + C) * 2u; voffB[i] = (unsigned)(Rb * K + C) * 2u; }
    const size_t kstep = (size_t)(BK * 2);
    const size_t hstep = (size_t)HALF * K * 2;
    const size_t tstep = 2 * hstep;
    const unsigned ldsw = (unsigned)wid * 1024u;
    const int aoff = lds_byte(wr * 64 + fr, fq * 8), boff = lds_byte(wc * 32 + fr, fq * 8);
#define PG8_SA(b, h) (((b) * 2 + (h)) * HTB)
#define PG8_SB(b, h) ((4 + (b) * 2 + (h)) * HTB)
#define PG8_STAGE(bufoff, gbase, voff) do { _Pragma("unroll") for (int _i = 0; _i < 2; ++_i) \
        __builtin_amdgcn_global_load_lds((const unsigned*)((const char*)(gbase) + (voff)[_i]), (PG8_LAS unsigned*)(lds + (bufoff) + ldsw + _i * 8192), 16, 0, 0); } while (0)
#define PG8_LDA(dst, b, h) do { _Pragma("unroll") for (int m = 0; m < 4; ++m) _Pragma("unroll") for (int k = 0; k < 2; ++k) dst[m][k] = *(const PG8_LAS bf16x8*)(lds + PG8_SA(b, h) + aoff + m * 2048 + k * 1024); } while (0)
#define PG8_LDB(dst, b, h) do { _Pragma("unroll") for (int n = 0; n < 2; ++n) _Pragma("unroll") for (int k = 0; k < 2; ++k) dst[n][k] = *(const PG8_LAS bf16x8*)(lds + PG8_SB(b, h) + boff + n * 2048 + k * 1024); } while (0)
#define PG8_MMA(ai, bj, At, Bt) do { __builtin_amdgcn_s_setprio(1); _Pragma("unroll") for (int m = 0; m < 4; ++m) _Pragma("unroll") for (int n = 0; n < 2; ++n) _Pragma("unroll") for (int k = 0; k < 2; ++k) \
        acc[ai][bj][m][n] = __builtin_amdgcn_mfma_f32_16x16x32_bf16(Bt[n][k], At[m][k], acc[ai][bj][m][n], 0, 0, 0); __builtin_amdgcn_s_setprio(0); } while (0)
#define PG8_WAIT_V(n) asm volatile("s_waitcnt vmcnt(" #n ")" ::: "memory")
#define PG8_WAIT_L(n) asm volatile("s_waitcnt lgkmcnt(" #n ")" ::: "memory")
#define PG8_BAR __builtin_amdgcn_s_barrier()
#define PG8_SCHED __builtin_amdgcn_sched_barrier(0)
    Unit cur, nxt; int ui = 0;
    if (!S.next(0, cur)) return;
    f32x4 acc[2][2][4][2];
#pragma unroll
    for (int a = 0; a < 2; ++a)
#pragma unroll
        for (int b = 0; b < 2; ++b)
#pragma unroll
            for (int m = 0; m < 4; ++m)
#pragma unroll
                for (int n = 0; n < 2; ++n) acc[a][b][m][n] = (f32x4){0.f, 0.f, 0.f, 0.f};
    bf16x8 At[4][2], B0[2][2], B1[2][2];
    const char* cA = (const char*)g.A + (size_t)cur.pm * tstep + (size_t)cur.koff * 2; const char* cB = (const char*)g.Bt + (size_t)cur.pn * tstep + (size_t)cur.koff * 2;
    S.a_ready(cur);
    PG8_STAGE(PG8_SB(0, 0), cB, voffB); PG8_STAGE(PG8_SA(0, 0), cA, voffA); PG8_STAGE(PG8_SB(0, 1), cB + hstep, voffB); PG8_STAGE(PG8_SA(0, 1), cA + hstep, voffA);
    if (wr == 1) PG8_BAR;
    PG8_WAIT_V(4); PG8_BAR;
    PG8_STAGE(PG8_SB(1, 0), cB + kstep, voffB); PG8_STAGE(PG8_SA(1, 0), cA + kstep, voffA); PG8_STAGE(PG8_SB(1, 1), cB + hstep + kstep, voffB);
    PG8_WAIT_V(6); PG8_BAR;
    PG8_STAMP();
    for (;;) {
        const bool has_next = S.next(ui + 1, nxt);
        const char* nA = has_next ? (const char*)g.A + (size_t)nxt.pm * tstep + (size_t)nxt.koff * 2 : cA; const char* nB = has_next ? (const char*)g.Bt + (size_t)nxt.pn * tstep + (size_t)nxt.koff * 2 : cB;
        const int ntc = cur.klen ? cur.klen / BK : nt;
        for (int t = 0; t < ntc; t += 2) {
            const bool last = (t == ntc - 2);
            const char* a1 = cA + (size_t)(t + 1) * kstep;
            const char* a2 = last ? nA : cA + (size_t)(t + 2) * kstep; const char* b2 = last ? nB : cB + (size_t)(t + 2) * kstep;
            const char* a3 = a2 + kstep; const char* b3 = b2 + kstep;
            if (last && has_next) S.a_ready(nxt);
            PG8_LDB(B0, 0, 0); PG8_SCHED; PG8_LDA(At, 0, 0); PG8_STAGE(PG8_SA(1, 1), a1 + hstep, voffA);
            PG8_WAIT_L(8); PG8_BAR; PG8_WAIT_L(0); PG8_MMA(0, 0, At, B0); PG8_BAR; PG8_SCHED;
            PG8_LDB(B1, 0, 1); PG8_STAGE(PG8_SB(0, 0), b2, voffB);
            PG8_BAR; PG8_WAIT_L(0); PG8_MMA(0, 1, At, B1); PG8_BAR;
            PG8_LDA(At, 0, 1); PG8_STAGE(PG8_SA(0, 0), a2, voffA);
            PG8_BAR; PG8_WAIT_L(0); PG8_MMA(1, 0, At, B0); PG8_BAR; PG8_SCHED;
            PG8_STAGE(PG8_SB(0, 1), b2 + hstep, voffB);
            PG8_WAIT_V(6); PG8_BAR; PG8_MMA(1, 1, At, B1); PG8_BAR;
            PG8_LDB(B0, 1, 0); PG8_SCHED; PG8_LDA(At, 1, 0); PG8_STAGE(PG8_SA(0, 1), a2 + hstep, voffA);
            PG8_WAIT_L(8); PG8_BAR; PG8_WAIT_L(0); PG8_MMA(0, 0, At, B0); PG8_BAR; PG8_SCHED;
            PG8_LDB(B1, 1, 1); PG8_STAGE(PG8_SB(1, 0), b3, voffB);
            PG8_BAR; PG8_WAIT_L(0); PG8_MMA(0, 1, At, B1); PG8_BAR;
            PG8_LDA(At, 1, 1); PG8_STAGE(PG8_SA(1, 0), a3, voffA);
            PG8_BAR; PG8_WAIT_L(0); PG8_MMA(1, 0, At, B0); PG8_BAR; PG8_SCHED;
            PG8_STAGE(PG8_SB(1, 1), b3 + hstep, voffB);
            PG8_WAIT_V(6); PG8_BAR; PG8_MMA(1, 1, At, B1); PG8_BAR;
        }
        PG8_STAMP();
        if constexpr (!Epi::AFTER_DRAIN) { E(acc, cur, wr, wc, fr, fq); S.done(cur); }
        PG8_STAMP();
        if (!has_next) break;
#pragma unroll
        for (int a = 0; a < 2; ++a)
#pragma unroll
            for (int b = 0; b < 2; ++b)
#pragma unroll
                for (int m = 0; m < 4; ++m)
#pragma unroll
                    for (int n = 0; n < 2; ++n) acc[a][b][m][n] = (f32x4){0.f, 0.f, 0.f, 0.f};
        cur = nxt; cA = nA; cB = nB; ++ui;
    }
    PG8_WAIT_V(0);
    if (wr == 0) PG8_BAR;
    PG8_BAR;
    if constexpr (Epi::AFTER_DRAIN) { E.fused(acc, cur, wr, wc, fr, fq, lds, wid, lane); S.done(cur); }
    PG8_STAMP();
    if (STAMP && wid == 0) { stamps[lane] = lane < nts ? (((unsigned long long)(unsigned)ts_hi << 32) | (unsigned)ts_lo) : 0ull;
        if (lane == 62) stamps[62] = rt_entry; if (lane == 63) stamps[63] = (unsigned long long)wall_clock64(); }
#undef PG8_STAMP
#undef PG8_SA
#undef PG8_SB
#undef PG8_STAGE
#undef PG8_LDA
#undef PG8_LDB
#undef PG8_MMA
#undef PG8_WAIT_V
#undef PG8_WAIT_L
#undef PG8_BAR
#undef PG8_SCHED
}
}
namespace cg = cooperative_groups;
using pg8::bf16_t; using pg8::bf16x8; using pg8::f32x4; using pg8::u32x4; using pg8::Unit;
#define LAS __attribute__((address_space(3)))
typedef short s16x4 __attribute__((ext_vector_type(4)));
typedef unsigned u32x2 __attribute__((ext_vector_type(2)));
typedef __bf16 bf2_t __attribute__((ext_vector_type(2)));
typedef float f2_t __attribute__((ext_vector_type(2)));
#define DI __device__ __forceinline__

constexpr int DM = 1024, SEQ = 2048, NMETA = 16, TPR = 2064, ROWS_P = 16512, ROWS_S = 1024, T = 17536, TP = 17664;
constexpr int DPROJ = 7176;
constexpr size_t O_YP = 0, O_YS = 16777216, O_PP = O_YS + 1048576, O_CP = O_PP + 122880, O_NP = O_CP + 2097152, O_MP = O_NP + 8192,
                 O_PS = O_MP + 32, O_CS = O_PS + 1966080, O_NS = O_CS + 33554432, O_MS = O_NS + 131072;
constexpr size_t SZ_ACT = (size_t)TP * 1024 * 2;
constexpr size_t W_XN = 0, W_WIN = W_XN + SZ_ACT, W_WOUT = W_WIN + (size_t)7168 * 1024 * 2, W_WPOOL = W_WOUT + (size_t)1024 * 2048 * 2,
                 W_GATES = W_WPOOL + 524288, W_U = W_GATES + (size_t)TP * 32, W_ZA = W_U + SZ_ACT, W_Q = W_ZA + SZ_ACT, W_K = W_Q + SZ_ACT,
                 W_V = W_K + SZ_ACT, W_G = W_V + SZ_ACT, W_HT = W_G + SZ_ACT, W_Y = W_HT + SZ_ACT, W_RSS = W_Y + 2 * SZ_ACT,
                 W_CTR = W_RSS + (size_t)TP * 64, W_BAR = W_CTR + 256, W_END = W_BAR + 16384;
constexpr int LDS_BYTES = 143872 + 16, L_XB = 143872;

struct Params {
    const float *x_prompt, *x_sample, *state_pool, *state_C, *state_n, *state_m, *meta, *norm1_w, *w_in, *b_if, *w_pool, *pool_scale, *mhln_w, *w_out, *normf_w;
    float* out;
    unsigned char* ws;
    int phase_lo, phase_hi;
};

DI int opaque_tid() { int t = threadIdx.x; asm volatile("" : "+v"(t)); return t; }
DI unsigned pk_bf16(float lo, float hi) { f2_t v = {lo, hi}; bf2_t r = __builtin_convertvector(v, bf2_t); return __builtin_bit_cast(unsigned, r); }
DI float bf_lo(unsigned u) { return __uint_as_float(u << 16); }
DI float bf_hi(unsigned u) { return __uint_as_float(u & 0xffff0000u); }
DI float bf2f(short s) { return __uint_as_float(((unsigned)(unsigned short)s) << 16); }
DI float wave_sum(float v) { for (int o = 32; o; o >>= 1) v += __shfl_xor(v, o); return v; }
DI float sigmoidf_(float x) { return __builtin_amdgcn_rcpf(1.f + __expf(-x)); }
DI float siluf_(float x) { return x * sigmoidf_(x); }
DI float gate2_(float o, float z) { return z * __builtin_amdgcn_rcpf((1.f + __expf(-o)) * (1.f + __expf(-z))); }
DI f32x4 mfma16(bf16x8 a, bf16x8 b, f32x4 c) { return __builtin_amdgcn_mfma_f32_16x16x32_bf16(a, b, c, 0, 0, 0); }
DI s16x4 tr_read(const LAS unsigned char* a) { return __builtin_amdgcn_ds_read_tr16_b64_v4i16((LAS s16x4*)a); }
DI bf16x8 cat8(s16x4 lo, s16x4 hi) { return __builtin_shufflevector(lo, hi, 0, 1, 2, 3, 4, 5, 6, 7); }

#define XB_TMO      128
#define XB_XCNT(j)  (256  + 64 * (j))
#define XB_XSUB(j)  (1280 + 64 * (j))
#define XB_XGEN(j)  (2304 + 64 * (j))
#define XB_TOP      3328
#define XB_TOPGEN   3392
#define XCD_BAR_WORDS 3456
#define XB_SPIN_CAP (1u << 18)

__device__ __forceinline__ unsigned xb_ld(unsigned* p)              { return __hip_atomic_load(p, __ATOMIC_RELAXED, __HIP_MEMORY_SCOPE_AGENT); }
__device__ __forceinline__ unsigned xb_add(unsigned* p, unsigned v) { return __hip_atomic_fetch_add(p, v, __ATOMIC_RELAXED, __HIP_MEMORY_SCOPE_AGENT); }
__device__ __forceinline__ unsigned xb_xcc_id() { return (unsigned)__builtin_amdgcn_s_getreg((3 << 11) | 20) & 0xFu; }
#define XB_SPIN(cond, bar) do { unsigned _sp = 0; while (cond) { __builtin_amdgcn_s_sleep(1); \
    if ((++_sp & 255u) == 0u) { if (xb_ld(&(bar)[XB_TMO])) break; if (_sp > XB_SPIN_CAP) { atomicAdd(&(bar)[XB_TMO], 1u); break; } } } } while (0)

struct XcdBarrier {
    unsigned* bar; unsigned x;
    volatile LAS unsigned* st;
};

__device__ __forceinline__ XcdBarrier xcd_barrier_post(unsigned* bar, volatile LAS unsigned* st) {
    XcdBarrier b; b.bar = bar; b.x = xb_xcc_id(); b.st = st;
    if (threadIdx.x == 0) (void)xb_add(&bar[XB_XCNT(b.x)], 1u);
    return b;
}
__device__ __forceinline__ void xcd_barrier_complete(unsigned* bar, unsigned x, unsigned& nloc, unsigned& nx) {
    const unsigned G = gridDim.x * gridDim.y * gridDim.z;
    unsigned sum, cnt, mine, sp = 0u;
    for (;;) {
        sum = 0u; cnt = 0u; mine = 0u;
#pragma unroll
        for (unsigned j = 0; j < 16; ++j) { const unsigned c = xb_ld(&bar[XB_XCNT(j)]); sum += c; cnt += (c > 0u) ? 1u : 0u; mine = (j == x) ? c : mine; }
        if (sum == G) break;
        __builtin_amdgcn_s_sleep(1);
        if ((++sp & 255u) == 0u) { if (xb_ld(&bar[XB_TMO])) break; if (sp > XB_SPIN_CAP) { atomicAdd(&bar[XB_TMO], 1u); break; } }
    }
    nloc = mine > 0u ? mine : 1u; nx = cnt > 0u ? cnt : 1u;
}

__device__ __forceinline__ void xcd_barrier(const XcdBarrier& b) {
    asm volatile("s_waitcnt vmcnt(0)" ::: "memory");
    __syncthreads();
    if (threadIdx.x == 0) {
        unsigned* bar = b.bar;
        __builtin_amdgcn_s_waitcnt(0);
        unsigned nloc = b.st[0], nx = b.st[1];
        if (nloc == 0u) { xcd_barrier_complete(bar, b.x, nloc, nx); b.st[0] = nloc; b.st[1] = nx; }
        const unsigned old = xb_add(&bar[XB_XSUB(b.x)], 1u);
        const unsigned gen = old / nloc;
        if (old + 1u == (gen + 1u) * nloc) {
            __builtin_amdgcn_fence(__ATOMIC_RELEASE, "agent");
            asm volatile("s_waitcnt vmcnt(0)" ::: "memory");
            const unsigned og = xb_add(&bar[XB_TOP], 1u);
            const unsigned tg = og / nx;
            if (og + 1u == (tg + 1u) * nx) xb_add(&bar[XB_TOPGEN], 1u);
            else XB_SPIN(xb_ld(&bar[XB_TOPGEN]) == tg, bar);
            __builtin_amdgcn_fence(__ATOMIC_ACQUIRE, "agent");
            xb_add(&bar[XB_XGEN(b.x)], 1u);
            asm volatile("s_waitcnt vmcnt(0)" ::: "memory");
        } else {
            XB_SPIN(xb_ld(&bar[XB_XGEN(b.x)]) == gen, bar);
            __builtin_amdgcn_fence(__ATOMIC_ACQUIRE, "agent");
            asm volatile("s_waitcnt vmcnt(0)" ::: "memory");
        }
    }
    __syncthreads();
}


DI const float* row_src(const Params& p, int r) {
    if (r < ROWS_P) { const int b = r / TPR, t = r - b * TPR; return t < NMETA ? p.meta + (size_t)t * DM : p.x_prompt + ((size_t)(b * SEQ + t - NMETA)) * DM; }
    return p.x_sample + (size_t)(r - ROWS_P) * DM;
}

DI void p0_rows(const Params& p, int u, LAS unsigned char* lds, const float4 (&wa)[4][4], const float4 (&wb)[4][4]) {
    (void)lds;
    const int tid = opaque_tid(), lane = tid & 63, wid = __builtin_amdgcn_readfirstlane(tid >> 6);
    bf16_t* XN = (bf16_t*)(p.ws + W_XN); float* GATES = (float*)(p.ws + W_GATES);
    const int rbase = u * 32 + wid * 4;
    float4 x[4][4]; float ss[4];
#pragma unroll
    for (int q = 0; q < 4; ++q) {
        const int r = rbase + q; const float* src = row_src(p, r < T ? r : T - 1);
#pragma unroll
        for (int j = 0; j < 4; ++j) { const f32x4 t_ = __builtin_nontemporal_load((const f32x4*)(src + 4 * lane + 256 * j)); x[q][j].x = t_[0]; x[q][j].y = t_[1]; x[q][j].z = t_[2]; x[q][j].w = t_[3]; }
    }
#pragma unroll
    for (int q = 0; q < 4; ++q) { float a = 0.f;
#pragma unroll
        for (int j = 0; j < 4; ++j) a += x[q][j].x * x[q][j].x + x[q][j].y * x[q][j].y + x[q][j].z * x[q][j].z + x[q][j].w * x[q][j].w;
        ss[q] = a; }
#pragma unroll
    for (int o = 32; o; o >>= 1) {
#pragma unroll
        for (int q = 0; q < 4; ++q) ss[q] += __shfl_xor(ss[q], o); }
#pragma unroll
    for (int q = 0; q < 4; ++q) {
        const int r = rbase + q;
        if (r >= T) { const u32x4 z = {0u, 0u, 0u, 0u}; *(u32x4*)(XN + (size_t)r * 1024 + lane * 16) = z; *(u32x4*)(XN + (size_t)r * 1024 + lane * 16 + 8) = z; continue; }
        const float rstd = rsqrtf(ss[q] * (1.f / 1024.f) + 1e-6f);
        float ga[8];
#pragma unroll
        for (int g = 0; g < 8; ++g) ga[g] = 0.f;
#pragma unroll
        for (int j = 0; j < 4; ++j) {
            const float4 nw = *(const float4*)(p.norm1_w + 4 * lane + 256 * j);
            float y[4]; y[0] = x[q][j].x * rstd * nw.x; y[1] = x[q][j].y * rstd * nw.y; y[2] = x[q][j].z * rstd * nw.z; y[3] = x[q][j].w * rstd * nw.w;
            u32x2 o; o.x = pk_bf16(y[0], y[1]); o.y = pk_bf16(y[2], y[3]);
            *(u32x2*)(XN + (size_t)r * 1024 + 4 * lane + 256 * j) = o;
#pragma unroll
            for (int e = 0; e < 4; ++e) { ga[0] += y[e] * wa[j][e].x; ga[1] += y[e] * wa[j][e].y; ga[2] += y[e] * wa[j][e].z; ga[3] += y[e] * wa[j][e].w;
                                          ga[4] += y[e] * wb[j][e].x; ga[5] += y[e] * wb[j][e].y; ga[6] += y[e] * wb[j][e].z; ga[7] += y[e] * wb[j][e].w; }
        }
        float h4[4], h2[2], h1;
        { const bool up = lane & 32;
#pragma unroll
          for (int g = 0; g < 4; ++g) { const float keep = up ? ga[4 + g] : ga[g], give = up ? ga[g] : ga[4 + g]; h4[g] = keep + __shfl_xor(give, 32); } }
        { const bool up = lane & 16;
#pragma unroll
          for (int g = 0; g < 2; ++g) { const float keep = up ? h4[2 + g] : h4[g], give = up ? h4[g] : h4[2 + g]; h2[g] = keep + __shfl_xor(give, 16); } }
        { const bool up = lane & 8; const float keep = up ? h2[1] : h2[0], give = up ? h2[0] : h2[1]; h1 = keep + __shfl_xor(give, 8); }
        h1 += __shfl_xor(h1, 4); h1 += __shfl_xor(h1, 2); h1 += __shfl_xor(h1, 1);
        if ((lane & 7) == 0) {
            const int g = ((lane >> 5) & 1) * 4 + ((lane >> 4) & 1) * 2 + ((lane >> 3) & 1);
            const float v = h1 + p.b_if[g];
            GATES[(size_t)r * 8 + g] = g < 4 ? v : fminf(v, 0.f) - log1pf(__expf(-fabsf(v)));
        }
    }
}

DI void p0_transpose(const float* src, int src_pitch, int cb0, int cb1, bool perm, float scale, bf16_t* dst, int dst_pitch, int k0, LAS unsigned char* lds) {
    LAS float* tile = (LAS float*)lds;
    const int tid = opaque_tid();
    const int c4 = (tid & 63) * 4, r0 = tid >> 6;
    const int scol = c4 < 128 ? cb0 + c4 : cb1 + c4 - 128;
#pragma unroll
    for (int i = 0; i < 8; ++i) { const int row = r0 + 8 * i; const f32x4 v = __builtin_nontemporal_load((const f32x4*)(src + (size_t)(k0 + row) * src_pitch + scol));
        tile[row * 257 + c4 + 0] = v[0]; tile[row * 257 + c4 + 1] = v[1]; tile[row * 257 + c4 + 2] = v[2]; tile[row * 257 + c4 + 3] = v[3]; }
    __syncthreads();
    const int kg = tid & 7;
#pragma unroll
    for (int i = 0; i < 4; ++i) {
        const int r = (tid >> 3) + 64 * i;
        const int c = perm ? ((r & ~31) + pg8::perm32(r & 31)) : r;
        float v[8];
#pragma unroll
        for (int j = 0; j < 8; ++j) v[j] = tile[(kg * 8 + j) * 257 + c] * scale;
        u32x4 o; o.x = pk_bf16(v[0], v[1]); o.y = pk_bf16(v[2], v[3]); o.z = pk_bf16(v[4], v[5]); o.w = pk_bf16(v[6], v[7]);
        *(u32x4*)(dst + (size_t)r * dst_pitch + k0 + kg * 8) = o;
    }
    __syncthreads();
}

constexpr int NU0_ROWS = TP / 32  , NU0_WIN = 28 * 16, NU0_WOUT = 4 * 32, NU0_WPOOL = 4 * 4, NU0 = NU0_ROWS + NU0_WIN + NU0_WPOOL;
DI void phase0(const Params& p, LAS unsigned char* lds) {
    if (blockIdx.x == 0 && threadIdx.x < 8) ((unsigned*)(p.ws + W_CTR))[threadIdx.x] = 0u;
    float4 wa[4][4], wb[4][4];
    {   const int lane_ = threadIdx.x & 63;
#pragma unroll
        for (int j = 0; j < 4; ++j)
#pragma unroll
            for (int e = 0; e < 4; ++e) { const float* wp = p.w_in + (size_t)(4 * lane_ + 256 * j + e) * DPROJ + 7168; wa[j][e] = *(const float4*)wp; wb[j][e] = *(const float4*)(wp + 4); } }
    for (int u = blockIdx.x; u < NU0; u += gridDim.x) {
        if (u < NU0_ROWS) p0_rows(p, u, lds, wa, wb);
        else if (u < NU0_ROWS + NU0_WIN) { const int i = u - NU0_ROWS, pn = i >> 4, kb = i & 15;
            const int cb0 = pn < 20 ? 256 * pn : 5120 + 128 * (pn - 20), cb1 = pn < 20 ? 256 * pn + 128 : 6144 + 128 * (pn - 20);
            p0_transpose(p.w_in, DPROJ, cb0, cb1, true, (pn >= 12 && pn < 16) ? 0.0625f : 1.f, (bf16_t*)(p.ws + W_WIN) + (size_t)pn * 256 * 1024, 1024, 64 * kb, lds); }
        else { const int i = u - NU0_ROWS - NU0_WIN, g = i >> 2, kb = i & 3;
            p0_transpose(p.w_pool + (size_t)g * 65536, 256, 0, 128, false, 1.f, (bf16_t*)(p.ws + W_WPOOL) + (size_t)g * 65536, 256, 64 * kb, lds); }
    }
}


struct SegOrder {
    int G, c, first, last;
    __device__ __forceinline__ static void map(int l, int nN, Unit& u) {
        const int nM = 69, nwg = nM * nN; int wgid = l;
        { const int q = nwg / 8, r = nwg % 8, xcd = wgid % 8, off = wgid / 8; wgid = (xcd < r ? xcd * (q + 1) : r * (q + 1) + (xcd - r) * q) + off; }
        const int nig = 8 * nN, gid = wgid / nig, fm = gid * 8, gsz = (nM - fm) < 8 ? (nM - fm) : 8;
        u.pm = fm + ((wgid % nig) % gsz); u.pn = (wgid % nig) / gsz; u.koff = 0; u.klen = 0;
    }
    __device__ __forceinline__ bool next(int i, Unit& u) const {
        const int L = first + i * G + c; if (L >= last) return false;
        if (L < 1380) map(L, 20, u); else { map(L - 1380, 8, u); u.pn += 20; }
        return true;
    }
    __device__ __forceinline__ void a_ready(const Unit&) const {}
    __device__ __forceinline__ void done(const Unit&) const {}
};
struct EpiG1 {
    static constexpr bool PERM = false, AFTER_DRAIN = false;
    bf16_t *U, *ZA, *Q, *K, *V, *G; const float* pool_scale;
    DI void operator()(const f32x4 (&acc)[2][2][4][2], const Unit& u, int wr, int wc, int fr, int fq) const {
        const int row0 = u.pm * 256 + wr * 64 + fr, cl = wc * 32 + 8 * fq;
        if (u.pn >= 20) {
            const int col = (u.pn - 20) * 128 + cl;
#pragma unroll
            for (int ai = 0; ai < 2; ++ai)
#pragma unroll
                for (int m = 0; m < 4; ++m) {
                    const int row = row0 + ai * 128 + m * 16;
                    float r[8];
#pragma unroll
                    for (int i = 0; i < 4; ++i) { r[i] = gate2_(acc[ai][0][m][0][i], acc[ai][1][m][0][i]); r[4 + i] = gate2_(acc[ai][0][m][1][i], acc[ai][1][m][1][i]); }
                    u32x4 o; o.x = pk_bf16(r[0], r[1]); o.y = pk_bf16(r[2], r[3]); o.z = pk_bf16(r[4], r[5]); o.w = pk_bf16(r[6], r[7]);
                    *(u32x4*)(G + (size_t)row * 1024 + col) = o;
                }
        } else {
            const int tsel = u.pn >> 2;
            bf16_t* base = tsel == 0 ? U : tsel == 1 ? ZA : tsel == 2 ? Q : tsel == 3 ? K : V;
#pragma unroll
            for (int bj = 0; bj < 2; ++bj) {
                const int col = (u.pn & 3) * 256 + bj * 128 + cl;
                float ps[8];
                if (tsel == 1) { const float4 a = *(const float4*)(pool_scale + col), b = *(const float4*)(pool_scale + col + 4); ps[0] = a.x; ps[1] = a.y; ps[2] = a.z; ps[3] = a.w; ps[4] = b.x; ps[5] = b.y; ps[6] = b.z; ps[7] = b.w; }
#pragma unroll
                for (int ai = 0; ai < 2; ++ai)
#pragma unroll
                    for (int m = 0; m < 4; ++m) {
                        const int row = row0 + ai * 128 + m * 16;
                        float r[8];
#pragma unroll
                        for (int i = 0; i < 4; ++i) { r[i] = acc[ai][bj][m][0][i]; r[4 + i] = acc[ai][bj][m][1][i]; }
                        if (tsel == 1) {
#pragma unroll
                            for (int i = 0; i < 8; ++i) r[i] = siluf_(r[i]) * ps[i];
                        }
                        u32x4 o; o.x = pk_bf16(r[0], r[1]); o.y = pk_bf16(r[2], r[3]); o.z = pk_bf16(r[4], r[5]); o.w = pk_bf16(r[6], r[7]);
                        *(u32x4*)(base + (size_t)row * 1024 + col) = o;
                    }
            }
        }
    }
};

struct G2Order {
    int G, c;
    __device__ __forceinline__ bool next(int i, Unit& u) const {
        const int L = i * G + c;
        if (L < 256) { u.pm = L >> 2; u.pn = L & 3; u.koff = 0; u.klen = 0; return true; }
        const int idx = L - 256; if (idx >= 160) return false;
        const int tile = idx >> 3; u.pm = 64 + (tile >> 2); u.pn = tile & 3; u.koff = (idx & 7) * 256; u.klen = 256; return true;
    }
    __device__ __forceinline__ void a_ready(const Unit&) const {}
    __device__ __forceinline__ void done(const Unit&) const {}
};
struct EpiG2 {
    static constexpr bool PERM = false, AFTER_DRAIN = false;
    const float* x_prompt; long xs_delta; float* out; float* part; float* rss; unsigned* pcnt; const float* normf_w;
    DI void operator()(const f32x4 (&acc)[2][2][4][2], const Unit& u, int wr, int wc, int fr, int fq) const {
        const int row0 = u.pm * 256 + wr * 64 + fr, col0 = u.pn * 256 + wc * 32 + 4 * fq;
        if (u.klen != 0) {
#pragma unroll
            for (int ai = 0; ai < 2; ++ai)
#pragma unroll
                for (int m = 0; m < 4; ++m) {
                    const int row = row0 + ai * 128 + m * 16;
                    if (row < T) { float* pp = part + ((size_t)(u.koff >> 8) * 1280 + (row - 16384)) * 1024;
#pragma unroll
                        for (int bj = 0; bj < 2; ++bj)
#pragma unroll
                            for (int n = 0; n < 2; ++n) { const int c = col0 + bj * 128 + n * 16; *(f32x4*)(pp + c) = acc[ai][bj][m][n]; } }
                }
            return;
        }
        f32x4 (&va)[2][2][4][2] = const_cast<f32x4 (&)[2][2][4][2]>(acc);
#pragma unroll
        for (int ai = 0; ai < 2; ++ai)
#pragma unroll
            for (int m = 0; m < 4; ++m) {
                const int row = row0 + ai * 128 + m * 16;
                const int b = row / TPR, t = row - b * TPR; const bool valid = t >= NMETA;
                const float* xin = x_prompt + ((long)(b * SEQ + t - NMETA)) * 1024;
                float ss = 0.f;
                if (valid) {
#pragma unroll
                    for (int bj = 0; bj < 2; ++bj)
#pragma unroll
                        for (int n = 0; n < 2; ++n) { const int c = col0 + bj * 128 + n * 16; const f32x4 v = va[ai][bj][m][n] + __builtin_nontemporal_load((const f32x4*)(xin + c)); va[ai][bj][m][n] = v; ss += v[0] * v[0] + v[1] * v[1] + v[2] * v[2] + v[3] * v[3]; }
                }
                ss += __shfl_xor(ss, 16); ss += __shfl_xor(ss, 32);
                if (valid && fq == 0) (void)__hip_atomic_fetch_add(rss + row, ss, __ATOMIC_RELAXED, __HIP_MEMORY_SCOPE_AGENT);
            }
        unsigned* cnt = pcnt + (u.pm * 2 + wr) * 4;
        asm volatile("s_waitcnt vmcnt(0)" ::: "memory");
        if ((threadIdx.x & 63) == 0) (void)__hip_atomic_fetch_add(cnt, 1u, __ATOMIC_RELAXED, __HIP_MEMORY_SCOPE_AGENT);
        for (unsigned sp = 0; sp < (1u << 22); ++sp) {
            const unsigned seen = (unsigned)__builtin_amdgcn_readfirstlane((int)__hip_atomic_load(cnt, __ATOMIC_RELAXED, __HIP_MEMORY_SCOPE_AGENT));
            if (seen >= 16u) break;
            __builtin_amdgcn_s_sleep(1);
        }
        asm volatile("" ::: "memory");
        f32x4 nw[2][2];
#pragma unroll
        for (int bj = 0; bj < 2; ++bj)
#pragma unroll
            for (int n = 0; n < 2; ++n) nw[bj][n] = *(const f32x4*)(normf_w + col0 + bj * 128 + n * 16);
#pragma unroll
        for (int ai = 0; ai < 2; ++ai)
#pragma unroll
            for (int m = 0; m < 4; ++m) {
                const int row = row0 + ai * 128 + m * 16;
                const int b = row / TPR, t = row - b * TPR; const bool valid = t >= NMETA;
                const long off = ((long)(b * SEQ + t - NMETA)) * 1024;
                if (valid) {
                    const float tot = __hip_atomic_load(rss + row, __ATOMIC_RELAXED, __HIP_MEMORY_SCOPE_AGENT);
                    const float rstd = rsqrtf(tot * (1.f / 1024.f) + 1e-6f);
#pragma unroll
                    for (int bj = 0; bj < 2; ++bj)
#pragma unroll
                        for (int n = 0; n < 2; ++n) { const int c = col0 + bj * 128 + n * 16;
                            __builtin_nontemporal_store(va[ai][bj][m][n] * rstd * nw[bj][n], (f32x4*)(out + off + c)); }
                }
            }
    }
};

constexpr int L_Q = 0, L_K = 33792, L_V = 68608, L_SW = 87040, L_AL = 96256, L_GG = 104704, L_MM = 113152, L_MP = 121600, L_NV = 121856,
              L_QD = 122880, L_DEN = 123136, L_WE = 123392, L_BL = 123648, L_PL = 123904, L_CTL = 124160, L_NB = 124416, L_NZ = 124928, L_OUT = 125440;
constexpr int QST = 528, KST = 544, VST = 288, SST = 144;

DI void lds_bar() { asm volatile("s_waitcnt lgkmcnt(0)" ::: "memory"); __builtin_amdgcn_s_barrier(); asm volatile("" ::: "memory"); }

DI void scan_unit(const Params& p, const int b, const int h, const int eh, LAS unsigned char* lds) {
    const int tid = opaque_tid(), lane = tid & 63, wid = __builtin_amdgcn_readfirstlane(tid >> 6), fr = lane & 15, fq = lane >> 4;
    constexpr int nch = 33;
    const int rowbase = b * TPR;
    const int ecol = h * 256 + eh * 128, e0 = 16 * wid;
    LAS float* AL = (LAS float*)(lds + L_AL); LAS float* GG = (LAS float*)(lds + L_GG); LAS float* MM = (LAS float*)(lds + L_MM); LAS float* MP = (LAS float*)(lds + L_MP);
    LAS float* NV = (LAS float*)(lds + L_NV); LAS float* QD = (LAS float*)(lds + L_QD); LAS float* DEN = (LAS float*)(lds + L_DEN);
    LAS float* BL = (LAS float*)(lds + L_BL); LAS float* PL = (LAS float*)(lds + L_PL);
    const float* GATES = (const float*)(p.ws + W_GATES);
    const bf16_t* Qg = (const bf16_t*)(p.ws + W_Q); const bf16_t* Kg = (const bf16_t*)(p.ws + W_K); const bf16_t* Vg = (const bf16_t*)(p.ws + W_V);
    bf16_t* HT = (bf16_t*)(p.ws + W_HT);
    constexpr int npos = nch * 64;
    const int ldr = tid >> 3, ldseg = tid & 7;
    u32x4 pq[4], pk[4], pv[2];
    const u32x4 z4 = {0u, 0u, 0u, 0u};
#define SCAN_ISSUE(cc) do { const int L_ = (cc) == 0 ? 16 : 64, t0_ = (cc) == 0 ? 0 : 16 + 64 * ((cc) - 1); const size_t grow_ = (size_t)(rowbase + t0_ + ldr) * 1024; \
        _Pragma("unroll") for (int i_ = 0; i_ < 4; ++i_) { pq[i_] = z4; pk[i_] = z4; if (ldr < L_) { pq[i_] = *(const u32x4*)(Qg + grow_ + h * 256 + (ldseg + 8 * i_) * 8); pk[i_] = *(const u32x4*)(Kg + grow_ + h * 256 + (ldseg + 8 * i_) * 8); } } \
        _Pragma("unroll") for (int i_ = 0; i_ < 2; ++i_) { pv[i_] = z4; if (ldr < L_) pv[i_] = *(const u32x4*)(Vg + grow_ + ecol + (ldseg + 8 * i_) * 8); } } while (0)
    SCAN_ISSUE(0);
    __syncthreads();
    for (int idx = tid; idx < npos; idx += 512) {
        const int c = idx >> 6, i = idx & 63;
        const int L = c == 0 ? 16 : 64;
        const int t = c == 0 ? i : 16 + 64 * (c - 1) + i;
        float lf = 0.f, ig = -INFINITY;
        if (i < L) { const float* g = GATES + (size_t)(rowbase + t) * 8; ig = g[h]; lf = g[4 + h]; }
        AL[idx] = lf; GG[idx] = ig;
    }
    if (tid < 256) { NV[tid] = 0.f; *(LAS unsigned*)(lds + L_NB + tid * 4) = 0u; }
    __syncthreads();
    if (tid < nch) {
        const int c = tid; const int L = c == 0 ? 16 : 64;
        float bs = 0.f, P = -INFINITY;
        for (int i = 0; i < L; ++i) { const int idx = c * 64 + i; bs += AL[idx]; const float g = GG[idx] - bs; P = fmaxf(P, g); AL[idx] = bs; GG[idx] = g; MM[idx] = P; }
        BL[c] = bs; PL[c] = P;
    }
    __syncthreads();
    if (tid == 0) { float m = 0.f; MP[0] = m; for (int c = 0; c < nch; ++c) { m = BL[c] + fmaxf(m, PL[c]); MP[c + 1] = m; } }
    __syncthreads();
    for (int idx = tid; idx < npos; idx += 512) {
        const int c = idx >> 6, i = idx & 63;
        const int L = c == 0 ? 16 : 64;
        if (i < L) { const float bt = AL[idx]; const float mt = bt + fmaxf(MP[c], MM[idx]); AL[idx] = bt - mt; MM[idx] = mt; }
        else { AL[idx] = 0.f; MM[idx] = 0.f; }
    }
    f32x4 C[16];
#pragma unroll
    for (int i = 0; i < 16; ++i) C[i] = (f32x4){0.f, 0.f, 0.f, 0.f};
    __syncthreads();
#define SCAN_OUT(cc) do { const int L_ = (cc) == 0 ? 16 : 64, t0_ = (cc) == 0 ? 0 : 16 + 64 * ((cc) - 1); const float dn_ = DEN[ldr]; \
        _Pragma("unroll") for (int i_ = 0; i_ < 2; ++i_) { const u32x4 v_ = *(const LAS u32x4*)(lds + L_OUT + ldr * VST + (ldseg + 8 * i_) * 16); u32x4 o_; \
            o_.x = pk_bf16(bf_lo(v_.x) * dn_, bf_hi(v_.x) * dn_); o_.y = pk_bf16(bf_lo(v_.y) * dn_, bf_hi(v_.y) * dn_); o_.z = pk_bf16(bf_lo(v_.z) * dn_, bf_hi(v_.z) * dn_); o_.w = pk_bf16(bf_lo(v_.w) * dn_, bf_hi(v_.w) * dn_); \
            if (ldr < L_) *(u32x4*)(HT + (size_t)(rowbase + t0_ + ldr) * 1024 + ecol + (ldseg + 8 * i_) * 8) = o_; } } while (0)
    for (int c = 0; c < nch; ++c) {
        const int L = c == 0 ? 16 : 64;
        const int gi = c * 64;
#pragma unroll
        for (int i = 0; i < 4; ++i) {
            const int c16 = ldseg + 8 * i, blk = c16 >> 2, g4 = (c16 & 3) * 2;
            const int s0 = 2 * (g4 & 3) + (g4 >> 2), s1 = 2 * ((g4 + 1) & 3) + ((g4 + 1) >> 2);
            u32x2 qa_, qb_; qa_.x = pq[i].x; qa_.y = pq[i].y; qb_.x = pq[i].z; qb_.y = pq[i].w;
            *(LAS u32x2*)(lds + L_Q + ldr * QST + blk * 64 + s0 * 8) = qa_; *(LAS u32x2*)(lds + L_Q + ldr * QST + blk * 64 + s1 * 8) = qb_;
            *(LAS u32x4*)(lds + L_K + ldr * KST + c16 * 16) = pk[i]; }
#pragma unroll
        for (int i = 0; i < 2; ++i) *(LAS u32x4*)(lds + L_V + ldr * VST + (ldseg + 8 * i) * 16) = pv[i];
        if (c + 1 < nch) SCAN_ISSUE(c + 1);
        lds_bar();
#define SB() __builtin_amdgcn_sched_barrier(0)
        {
            const int tt = wid >> 1;
            bf16x8 bq[8];
#pragma unroll
            for (int kk = 0; kk < 8; ++kk) { const LAS unsigned char* qp = lds + L_Q + (16 * tt + fr) * QST + kk * 64 + ((((fq & 1) << 2) | (fq >> 1)) * 8);
                bq[kk] = cat8(*(const LAS s16x4*)qp, *(const LAS s16x4*)(qp + 16)); }
#pragma unroll
            for (int si = 0; si < 2; ++si) {
                const int st = 2 * (wid & 1) + si;
                u32x2 outv = {0u, 0u};
                if (st <= tt) {
                    bf16x8 ak[8];
#pragma unroll
                    for (int kk = 0; kk < 8; ++kk) ak[kk] = *(const LAS bf16x8*)(lds + L_K + (16 * st + fr) * KST + (kk * 32 + fq * 8) * 2);
                    const int t = 16 * tt + fr; const float al = AL[gi + t];
                    const f32x4 g4 = *(const LAS f32x4*)(GG + gi + 16 * st + 4 * fq);
                    SB();
                    f32x4 a = {0.f, 0.f, 0.f, 0.f}, a2 = {0.f, 0.f, 0.f, 0.f};
#pragma unroll
                    for (int kk = 0; kk < 8; kk += 2) { a = mfma16(ak[kk], bq[kk], a); a2 = mfma16(ak[kk + 1], bq[kk + 1], a2); }
                    a += a2;
                    float w[4];
#pragma unroll
                    for (int j = 0; j < 4; ++j) { const int sx = 16 * st + 4 * fq + j; w[j] = (sx <= t) ? a[j] * __expf(al + g4[j]) : 0.f; }
                    outv.x = pk_bf16(w[0], w[1]); outv.y = pk_bf16(w[2], w[3]);
                }
                *(LAS u32x2*)(lds + L_SW + (16 * tt + fr) * SST + (16 * st + 4 * fq) * 2) = outv;
                SB();
            }
        }
        f32x4 num[4];
#pragma unroll
        for (int mt = 0; mt < 4; ++mt) num[mt] = (f32x4){0.f, 0.f, 0.f, 0.f};
        {
            bf16x8 qf[2][4], nf[2], pf[2]; f32x4 qacc = {0.f, 0.f, 0.f, 0.f};
            const bool qdw = wid < 4;
            const LAS unsigned char* nbp = lds + (fr == 0 ? L_NB : L_NZ) + (8 * fq) * 2;
            const LAS unsigned char* qdp = lds + L_Q + (16 * (wid & 3) + fr) * QST + (8 * fq) * 2;
#define QLOAD(buf, k_) do { _Pragma("unroll") for (int mt = 0; mt < 4; ++mt) qf[buf][mt] = *(const LAS bf16x8*)(lds + L_Q + (16 * mt + fr) * QST + (32 * (k_) + 8 * fq) * 2); \
                if (qdw) { nf[buf] = *(const LAS bf16x8*)(nbp + (k_) * 64); pf[buf] = *(const LAS bf16x8*)(qdp + (k_) * 64); } } while (0)
            QLOAD(0, 0);
#pragma unroll
            for (int kk = 0; kk < 8; ++kk) {
                if (kk < 7) QLOAD((kk + 1) & 1, kk + 1);
                u32x4 bc; bc.x = pk_bf16(C[2 * kk][0], C[2 * kk][1]); bc.y = pk_bf16(C[2 * kk][2], C[2 * kk][3]); bc.z = pk_bf16(C[2 * kk + 1][0], C[2 * kk + 1][1]); bc.w = pk_bf16(C[2 * kk + 1][2], C[2 * kk + 1][3]);
                const bf16x8 cfrag = __builtin_bit_cast(bf16x8, bc);
                SB();
#pragma unroll
                for (int mt = 0; mt < 4; ++mt) num[mt] = mfma16(cfrag, qf[kk & 1][mt], num[mt]);
                if (qdw) qacc = mfma16(nf[kk & 1], pf[kk & 1], qacc);
                SB();
            }
#undef QLOAD
            if (qdw && fq == 0) QD[16 * wid + fr] = qacc[0];
        }
        if (c > 0) SCAN_OUT(c - 1);
        lds_bar();
        const float mprev = MP[c];
        const float alast = AL[gi + L - 1];
        const float decay = __expf(alast + mprev);
        bf16x8 vb[2], vw[2], wn[2], swa[6];
        {
            s16x4 v0[2], v1[2]; f32x4 g0[2], g1[2]; float sc[4];
#pragma unroll
            for (int kk = 0; kk < 2; ++kk) {
                const LAS unsigned char* base = lds + L_V + (32 * kk + 4 * fq + (fr >> 2)) * VST + (e0 + 4 * (fr & 3)) * 2;
                v0[kk] = tr_read(base); v1[kk] = tr_read(base + 16 * VST);
                g0[kk] = *(const LAS f32x4*)(GG + gi + 32 * kk + 4 * fq); g1[kk] = *(const LAS f32x4*)(GG + gi + 32 * kk + 16 + 4 * fq);
            }
#pragma unroll
            for (int mt = 0; mt < 4; ++mt) sc[mt] = AL[gi + 16 * mt + fr];
#define SWF(row, k0) cat8(*(const LAS s16x4*)(lds + L_SW + ((row) + fr) * SST + ((k0) + 4 * fq) * 2), *(const LAS s16x4*)(lds + L_SW + ((row) + fr) * SST + ((k0) + 16 + 4 * fq) * 2))
            swa[0] = SWF(0, 0); swa[1] = SWF(16, 0); swa[2] = SWF(32, 0); swa[3] = SWF(32, 32); swa[4] = SWF(48, 0); swa[5] = SWF(48, 32);
#undef SWF
            SB();
#pragma unroll
            for (int mt = 0; mt < 4; ++mt) { const float e = __expf(sc[mt] + mprev);
#pragma unroll
                for (int j = 0; j < 4; ++j) num[mt][j] *= e; }
#pragma unroll
            for (int kk = 0; kk < 2; ++kk) {
                vb[kk] = cat8(v0[kk], v1[kk]);
                float f[8], we[8];
#pragma unroll
                for (int j = 0; j < 4; ++j) { we[j] = __expf(alast + g0[kk][j]); we[4 + j] = __expf(alast + g1[kk][j]); f[j] = bf2f(vb[kk][j]) * we[j]; f[4 + j] = bf2f(vb[kk][4 + j]) * we[4 + j]; }
                u32x4 o; o.x = pk_bf16(f[0], f[1]); o.y = pk_bf16(f[2], f[3]); o.z = pk_bf16(f[4], f[5]); o.w = pk_bf16(f[6], f[7]);
                vw[kk] = __builtin_bit_cast(bf16x8, o);
                u32x4 wo; wo.x = pk_bf16(we[0], we[1]); wo.y = pk_bf16(we[2], we[3]); wo.z = pk_bf16(we[4], we[5]); wo.w = pk_bf16(we[6], we[7]);
                if (fr != 0) { wo.x = 0u; wo.y = 0u; wo.z = 0u; wo.w = 0u; }
                wn[kk] = __builtin_bit_cast(bf16x8, wo);
            }
        }
        {
            const int t = wid * 8 + (lane >> 3), part = lane & 7;
            const bf16x8 v = *(const LAS bf16x8*)(lds + L_SW + t * SST + part * 16);
            float rs = 0.f;
#pragma unroll
            for (int j = 0; j < 8; ++j) rs += bf2f(v[j]);
            rs += __shfl_xor(rs, 1); rs += __shfl_xor(rs, 2); rs += __shfl_xor(rs, 4);
            if (part == 0) { const float inter = __expf(AL[gi + t] + mprev);
                DEN[t] = __fdividef(1.f, fmaxf(fabsf(inter * QD[t] + rs), __expf(-MM[gi + t]))); }
        }
        num[0] = mfma16(vb[0], swa[0], num[0]); num[1] = mfma16(vb[0], swa[1], num[1]);
        num[2] = mfma16(vb[0], swa[2], num[2]); num[2] = mfma16(vb[1], swa[3], num[2]);
        num[3] = mfma16(vb[0], swa[4], num[3]); num[3] = mfma16(vb[1], swa[5], num[3]);
#pragma unroll
        for (int mt = 0; mt < 4; ++mt) { u32x2 o; o.x = pk_bf16(num[mt][0], num[mt][1]); o.y = pk_bf16(num[mt][2], num[mt][3]);
            *(LAS u32x2*)(lds + L_OUT + (16 * mt + fr) * VST + (e0 + 4 * fq) * 2) = o; }
        {
            s16x4 ka[2][8];
            const LAS unsigned char* kb0 = lds + L_K + (4 * fq + (fr >> 2)) * KST + (4 * (fr & 3)) * 2;
#define KLOAD(buf, ii) do { _Pragma("unroll") for (int h_ = 0; h_ < 2; ++h_) { ka[buf][4 * h_ + 0] = tr_read(kb0 + ((ii) + h_) * 32); ka[buf][4 * h_ + 1] = tr_read(kb0 + ((ii) + h_) * 32 + 16 * KST); \
                ka[buf][4 * h_ + 2] = tr_read(kb0 + ((ii) + h_) * 32 + 32 * KST); ka[buf][4 * h_ + 3] = tr_read(kb0 + ((ii) + h_) * 32 + 48 * KST); } } while (0)
            f32x4 nacc[2] = {{0.f, 0.f, 0.f, 0.f}, {0.f, 0.f, 0.f, 0.f}};
            KLOAD(0, 0);
#pragma unroll
            for (int ip = 0; ip < 8; ++ip) {
                const int i = 2 * ip;
                if (ip < 7) KLOAD((ip + 1) & 1, i + 2);
                C[i] *= decay; C[i + 1] *= decay;
                SB();
                C[i] = mfma16(cat8(ka[ip & 1][0], ka[ip & 1][1]), vw[0], C[i]);
                C[i + 1] = mfma16(cat8(ka[ip & 1][4], ka[ip & 1][5]), vw[0], C[i + 1]);
                C[i] = mfma16(cat8(ka[ip & 1][2], ka[ip & 1][3]), vw[1], C[i]);
                C[i + 1] = mfma16(cat8(ka[ip & 1][6], ka[ip & 1][7]), vw[1], C[i + 1]);
                if (ip == wid) {
                    nacc[0] = mfma16(cat8(ka[ip & 1][0], ka[ip & 1][1]), wn[0], nacc[0]); nacc[1] = mfma16(cat8(ka[ip & 1][4], ka[ip & 1][5]), wn[0], nacc[1]);
                    nacc[0] = mfma16(cat8(ka[ip & 1][2], ka[ip & 1][3]), wn[1], nacc[0]); nacc[1] = mfma16(cat8(ka[ip & 1][6], ka[ip & 1][7]), wn[1], nacc[1]);
                }
                SB();
            }
#undef KLOAD
            if (fr == 0) {
#pragma unroll
                for (int ii = 0; ii < 2; ++ii) { LAS f32x4* np = (LAS f32x4*)(NV + 32 * wid + 16 * ii + 4 * fq); const f32x4 o = *np * decay + nacc[ii]; *np = o;
                    u32x2 ob; ob.x = pk_bf16(o[0], o[1]); ob.y = pk_bf16(o[2], o[3]); *(LAS u32x2*)(lds + L_NB + (32 * wid + 8 * fq + 4 * ii) * 2) = ob; }
            }
        }
#undef SB
        lds_bar();
    }
    SCAN_OUT(nch - 1);
#undef SCAN_ISSUE
#undef SCAN_OUT
    float* Cout = p.out + O_CP + (((size_t)b * 4 + h) * 256) * 256 + eh * 128 + e0;
    const unsigned cl_off = (unsigned)(4 * fq * 256 + fr);
#pragma unroll
    for (int i = 0; i < 16; ++i)
#pragma unroll
        for (int j = 0; j < 4; ++j) __builtin_nontemporal_store(C[i][j], &(Cout + (size_t)i * 4096)[cl_off + j * 256]);
    if (eh == 0) {
        if (tid < 256) (p.out + O_NP)[((size_t)b * 4 + h) * 256 + tid] = NV[tid];
        if (tid == 0) (p.out + O_MP)[b * 4 + h] = MP[nch];
    }
    __syncthreads();
}

constexpr int SWR = 10240, SW_K = 0, SW_Q = 4224, SW_V = 8448, SW_F = 8832;
DI void sample_wave_unit(const Params& p, const int item, LAS unsigned char* wl) {
    int lane = threadIdx.x & 63; asm volatile("" : "+v"(lane));
    const int fr = lane & 15, fq = lane >> 4, rr = fr & 7;
    const int es = item & 15, h = (item >> 4) & 3, b = item >> 6, bh = b * 4 + h, e0 = 16 * es, rowbase = ROWS_P + b * 8;
    const float* GATES = (const float*)(p.ws + W_GATES);
    const bf16_t* Qg = (const bf16_t*)(p.ws + W_Q); const bf16_t* Kg = (const bf16_t*)(p.ws + W_K); const bf16_t* Vg = (const bf16_t*)(p.ws + W_V);
    bf16_t* HT = (bf16_t*)(p.ws + W_HT);
    LAS float* AL = (LAS float*)(wl + SW_F); LAS float* GG = AL + 8; LAS float* MM = AL + 16;
    f32x4 C[16];
    const unsigned cl_off = (unsigned)(4 * fq * 256 + fr);
    { const float* Cs = p.state_C + ((size_t)bh * 256) * 256 + e0;
#pragma unroll
      for (int i = 0; i < 16; ++i)
#pragma unroll
          for (int j = 0; j < 4; ++j) C[i][j] = (Cs + (size_t)i * 4096)[cl_off + j * 256]; }
    { const int r = lane >> 3, seg = lane & 7; const size_t grow = (size_t)(rowbase + r) * 1024 + h * 256;
#pragma unroll
      for (int i = 0; i < 4; ++i) { const int c16 = seg + 8 * i;
          *(LAS u32x4*)(wl + SW_K + r * QST + c16 * 16) = *(const u32x4*)(Kg + grow + c16 * 8);
          *(LAS u32x4*)(wl + SW_Q + r * QST + c16 * 16) = *(const u32x4*)(Qg + grow + c16 * 8); }
      if (lane < 16) { const int vr = lane >> 1, hf = lane & 1; *(LAS u32x4*)(wl + SW_V + vr * 48 + hf * 16) = *(const u32x4*)(Vg + (size_t)(rowbase + vr) * 1024 + h * 256 + e0 + hf * 8); } }
    const float mprev = p.state_m[bh];
    {
        const int t = lane & 7; const float* g = GATES + (size_t)(rowbase + t) * 8; const float ig = g[h]; float bs = g[4 + h];
#pragma unroll
        for (int o = 1; o < 8; o <<= 1) { const float v = __shfl_up(bs, o, 8); if (t >= o) bs += v; }
        const float gg = ig - bs; float P = gg;
#pragma unroll
        for (int o = 1; o < 8; o <<= 1) { const float v = __shfl_up(P, o, 8); if (t >= o) P = fmaxf(P, v); }
        const float mt = bs + fmaxf(mprev, P);
        if (lane < 8) { AL[t] = bs - mt; GG[t] = gg; MM[t] = mt; }
    }
    asm volatile("" ::: "memory");
    const float alast = AL[7], decay = __expf(alast + mprev), al_t = AL[rr];
    const f32x4 g4 = *(const LAS f32x4*)(GG + 4 * (fq & 1));
    f32x4 a = {0.f, 0.f, 0.f, 0.f};
#pragma unroll
    for (int kk = 0; kk < 8; ++kk) {
        const bf16x8 ak = *(const LAS bf16x8*)(wl + SW_K + rr * QST + (kk * 32 + fq * 8) * 2);
        const bf16x8 bq = *(const LAS bf16x8*)(wl + SW_Q + rr * QST + (kk * 32 + fq * 8) * 2);
        a = mfma16(ak, bq, a);
    }
    float w[4], rs = 0.f;
#pragma unroll
    for (int j = 0; j < 4; ++j) { const int sx = 4 * fq + j; w[j] = (fq < 2 && fr < 8 && sx <= fr) ? a[j] * __expf(al_t + g4[j]) : 0.f; rs += w[j]; }
    rs += __shfl_xor(rs, 16); rs += __shfl_xor(rs, 32);
    u32x4 swu; swu.x = pk_bf16(w[0], w[1]); swu.y = pk_bf16(w[2], w[3]); swu.z = 0u; swu.w = 0u;
    const bf16x8 swf = __builtin_bit_cast(bf16x8, swu);
    float qd = 0.f;
    {   const int part = lane >> 3; const float* nv = p.state_n + (size_t)bh * 256 + 32 * part;
#pragma unroll
        for (int i = 0; i < 4; ++i) { const bf16x8 q = *(const LAS bf16x8*)(wl + SW_Q + (lane & 7) * QST + (part * 4 + i) * 16);
            const float4 n0 = *(const float4*)(nv + 8 * i), n1 = *(const float4*)(nv + 8 * i + 4);
            qd += bf2f(q[0]) * n0.x + bf2f(q[1]) * n0.y + bf2f(q[2]) * n0.z + bf2f(q[3]) * n0.w + bf2f(q[4]) * n1.x + bf2f(q[5]) * n1.y + bf2f(q[6]) * n1.z + bf2f(q[7]) * n1.w; }
        qd += __shfl_xor(qd, 8); qd += __shfl_xor(qd, 16); qd += __shfl_xor(qd, 32); }
    const float inter = __expf(al_t + mprev);
    const float dn = __fdividef(1.f, fmaxf(fabsf(inter * qd + rs), __expf(-MM[rr])));
    f32x4 num = {0.f, 0.f, 0.f, 0.f};
#pragma unroll
    for (int kk = 0; kk < 8; ++kk) {
        u32x4 bc; bc.x = pk_bf16(C[2 * kk][0], C[2 * kk][1]); bc.y = pk_bf16(C[2 * kk][2], C[2 * kk][3]); bc.z = pk_bf16(C[2 * kk + 1][0], C[2 * kk + 1][1]); bc.w = pk_bf16(C[2 * kk + 1][2], C[2 * kk + 1][3]);
        const s16x4 lo = *(const LAS s16x4*)(wl + SW_Q + rr * QST + (32 * kk + 4 * fq) * 2);
        const s16x4 hi = *(const LAS s16x4*)(wl + SW_Q + rr * QST + (32 * kk + 16 + 4 * fq) * 2);
        num = mfma16(__builtin_bit_cast(bf16x8, bc), cat8(lo, hi), num);
    }
#pragma unroll
    for (int j = 0; j < 4; ++j) num[j] *= inter;
    const s16x4 zero4 = {0, 0, 0, 0};
    const s16x4 v4 = tr_read(wl + SW_V + (4 * (fq & 1) + (fr >> 2)) * 48 + (4 * (fr & 3)) * 2);
    num = mfma16(cat8(v4, zero4), swf, num);
    if (fr < 8) { u32x2 o; o.x = pk_bf16(num[0] * dn, num[1] * dn); o.y = pk_bf16(num[2] * dn, num[3] * dn);
        *(u32x2*)(HT + (size_t)(rowbase + fr) * 1024 + h * 256 + e0 + 4 * fq) = o; }
    u32x4 vwu; { float f[4];
#pragma unroll
        for (int j = 0; j < 4; ++j) f[j] = fq < 2 ? bf2f(v4[j]) * __expf(alast + g4[j]) : 0.f;
        vwu.x = pk_bf16(f[0], f[1]); vwu.y = pk_bf16(f[2], f[3]); vwu.z = 0u; vwu.w = 0u; }
    const bf16x8 vwf = __builtin_bit_cast(bf16x8, vwu);
    float* Cout = p.out + O_CS + ((size_t)bh * 256) * 256 + e0;
#pragma unroll
    for (int i = 0; i < 16; ++i) {
        const s16x4 k4 = tr_read(wl + SW_K + (4 * (fq & 1) + (fr >> 2)) * QST + (16 * i + 4 * (fr & 3)) * 2);
        C[i] = mfma16(cat8(k4, zero4), vwf, C[i] * decay);
#pragma unroll
        for (int j = 0; j < 4; ++j) __builtin_nontemporal_store(C[i][j], &(Cout + (size_t)i * 4096)[cl_off + j * 256]);
    }
    if (es == 0) {
        const float4 nn = *(const float4*)(p.state_n + (size_t)bh * 256 + 4 * lane);
        float n0 = decay * nn.x, n1 = decay * nn.y, n2 = decay * nn.z, n3 = decay * nn.w;
#pragma unroll
        for (int sx = 0; sx < 8; ++sx) { const float ws = __expf(alast + GG[sx]); const u32x2 kk = *(const LAS u32x2*)(wl + SW_K + sx * QST + lane * 8);
            n0 += ws * bf_lo(kk.x); n1 += ws * bf_hi(kk.x); n2 += ws * bf_lo(kk.y); n3 += ws * bf_hi(kk.y); }
        float4 o4; o4.x = n0; o4.y = n1; o4.z = n2; o4.w = n3;
        *(float4*)(p.out + O_NS + (size_t)bh * 256 + 4 * lane) = o4;
        if (lane == 0) (p.out + O_MS)[bh] = MM[7];
    }
    asm volatile("" ::: "memory");
}

DI void pool_unit(const Params& p, const int tile, const int g, LAS unsigned char* lds) {
    const int tid = opaque_tid(), lane = tid & 63, wid = __builtin_amdgcn_readfirstlane(tid >> 6), fr = lane & 15, fq = lane >> 4;
    const int w = 2 << g;
    const bf16_t* U = (const bf16_t*)(p.ws + W_U); const bf16_t* ZA = (const bf16_t*)(p.ws + W_ZA); bf16_t* Y = (bf16_t*)(p.ws + W_Y);
    bf16x8 bw[8][2];
    { const bf16_t* Wp = (const bf16_t*)(p.ws + W_WPOOL) + (size_t)g * 65536;
#pragma unroll
      for (int kk = 0; kk < 8; ++kk)
#pragma unroll
          for (int n = 0; n < 2; ++n) bw[kk][n] = *(const bf16x8*)(Wp + (size_t)(32 * wid + 16 * n + fr) * 256 + 32 * kk + 8 * fq); }
    __syncthreads();
    if (tile < ROWS_P / 64) {
        constexpr int L_US = L_K;
        const int R0 = tile * 64;
        for (int q = tid; q < 79 * 32; q += 512) { const int i = q >> 5, c16 = q & 31; int gr = R0 - 15 + i; gr = gr < 0 ? 0 : gr;
            *(LAS u32x4*)(lds + L_US + i * QST + c16 * 16) = *(const u32x4*)(U + (size_t)gr * 1024 + 256 * g + c16 * 8); }
        __syncthreads();
        for (int it = 0; it < 4; ++it) {
            const int item = tid + 512 * it, r = item >> 5, cg8 = item & 31;
            const int row = R0 + r, b = row / TPR, t = row - b * TPR, cnt = min(w, t + 1);
            float s[8], cur[8];
#pragma unroll
            for (int i = 0; i < 8; ++i) { s[i] = 0.f; cur[i] = 0.f; }
            for (int j = 0; j < cnt; ++j) {
                const u32x4 v = *(const LAS u32x4*)(lds + L_US + (r + 15 - j) * QST + cg8 * 16);
                const float f0 = bf_lo(v.x), f1 = bf_hi(v.x), f2 = bf_lo(v.y), f3 = bf_hi(v.y), f4 = bf_lo(v.z), f5 = bf_hi(v.z), f6 = bf_lo(v.w), f7 = bf_hi(v.w);
                s[0] += f0; s[1] += f1; s[2] += f2; s[3] += f3; s[4] += f4; s[5] += f5; s[6] += f6; s[7] += f7;
                if (j == 0) { cur[0] = f0; cur[1] = f1; cur[2] = f2; cur[3] = f3; cur[4] = f4; cur[5] = f5; cur[6] = f6; cur[7] = f7; }
            }
            const float inv = 1.f / (float)cnt;
            u32x4 o; o.x = pk_bf16(s[0] * inv - cur[0], s[1] * inv - cur[1]); o.y = pk_bf16(s[2] * inv - cur[2], s[3] * inv - cur[3]);
            o.z = pk_bf16(s[4] * inv - cur[4], s[5] * inv - cur[5]); o.w = pk_bf16(s[6] * inv - cur[6], s[7] * inv - cur[7]);
            *(LAS u32x4*)(lds + L_Q + r * QST + cg8 * 16) = o;
        }
    } else
    for (int it = 0; it < 4; ++it) {
        const int item = tid + 512 * it, r = item >> 5, cg8 = item & 31;
        const int row = tile * 64 + r, ch = 256 * g + 8 * cg8;
        const bool sample = row >= ROWS_P;
        int b, t, cnt;
        if (!sample) { b = row / TPR; t = row - b * TPR; cnt = min(w, t + 1); } else { const int si = row - ROWS_P; b = si >> 3; t = si & 7; cnt = w; }
        float s[8], cur[8];
#pragma unroll
        for (int i = 0; i < 8; ++i) { s[i] = 0.f; cur[i] = 0.f; }
        for (int j = 0; j < w; ++j) {
            if (j <= t) {
                const u32x4 v = *(const u32x4*)(U + (size_t)(row - j) * 1024 + ch);
                const float f0 = bf_lo(v.x), f1 = bf_hi(v.x), f2 = bf_lo(v.y), f3 = bf_hi(v.y), f4 = bf_lo(v.z), f5 = bf_hi(v.z), f6 = bf_lo(v.w), f7 = bf_hi(v.w);
                s[0] += f0; s[1] += f1; s[2] += f2; s[3] += f3; s[4] += f4; s[5] += f5; s[6] += f6; s[7] += f7;
                if (j == 0) { cur[0] = f0; cur[1] = f1; cur[2] = f2; cur[3] = f3; cur[4] = f4; cur[5] = f5; cur[6] = f6; cur[7] = f7; }
            } else if (sample) {
                const float* sp = p.state_pool + ((size_t)b * 15 + (15 + t - j)) * 1024 + ch;
                const float4 a = *(const float4*)sp, c4 = *(const float4*)(sp + 4);
                s[0] += a.x; s[1] += a.y; s[2] += a.z; s[3] += a.w; s[4] += c4.x; s[5] += c4.y; s[6] += c4.z; s[7] += c4.w;
            }
        }
        const float inv = 1.f / (float)cnt;
        u32x4 o; o.x = pk_bf16(s[0] * inv - cur[0], s[1] * inv - cur[1]); o.y = pk_bf16(s[2] * inv - cur[2], s[3] * inv - cur[3]);
        o.z = pk_bf16(s[4] * inv - cur[4], s[5] * inv - cur[5]); o.w = pk_bf16(s[6] * inv - cur[6], s[7] * inv - cur[7]);
        *(LAS u32x4*)(lds + L_Q + r * QST + cg8 * 16) = o;
    }
    __syncthreads();
    f32x4 acc[4][2];
#pragma unroll
    for (int mt = 0; mt < 4; ++mt) { acc[mt][0] = (f32x4){0.f, 0.f, 0.f, 0.f}; acc[mt][1] = (f32x4){0.f, 0.f, 0.f, 0.f}; }
    {
        bf16x8 af[2][4];
#pragma unroll
        for (int mt = 0; mt < 4; ++mt) af[0][mt] = *(const LAS bf16x8*)(lds + L_Q + (16 * mt + fr) * QST + (8 * fq) * 2);
#pragma unroll
        for (int kk = 0; kk < 8; ++kk) {
            if (kk < 7) {
#pragma unroll
                for (int mt = 0; mt < 4; ++mt) af[(kk + 1) & 1][mt] = *(const LAS bf16x8*)(lds + L_Q + (16 * mt + fr) * QST + (32 * (kk + 1) + 8 * fq) * 2);
            }
            __builtin_amdgcn_sched_barrier(0);
#pragma unroll
            for (int mt = 0; mt < 4; ++mt)
#pragma unroll
                for (int n = 0; n < 2; ++n) acc[mt][n] = mfma16(bw[kk][n], af[kk & 1][mt], acc[mt][n]);
            __builtin_amdgcn_sched_barrier(0);
        }
    }
#pragma unroll
    for (int mt = 0; mt < 4; ++mt) {
        const int row = tile * 64 + 16 * mt + fr;
#pragma unroll
        for (int n = 0; n < 2; ++n) {
            const int d = 256 * g + 32 * wid + 16 * n + 4 * fq;
            const u32x2 za = *(const u32x2*)(ZA + (size_t)row * 1024 + d);
            u32x2 o; o.x = pk_bf16(acc[mt][n][0] * bf_lo(za.x), acc[mt][n][1] * bf_hi(za.x)); o.y = pk_bf16(acc[mt][n][2] * bf_lo(za.y), acc[mt][n][3] * bf_hi(za.y));
            *(u32x2*)(Y + (size_t)row * 2048 + d) = o;
        }
    }
}

constexpr int N_ITEMS2 = 8192;
DI void gemm1_run(const Params& p, LAS unsigned char* lds, int G, int c, int first, int last) {
    pg8::Gemm g; g.A = (const bf16_t*)(p.ws + W_XN); g.Bt = (const bf16_t*)(p.ws + W_WIN); g.M = TP; g.N = 7168; g.K = 1024;
    SegOrder S; S.G = G; S.c = c; S.first = first; S.last = last;
    EpiG1 E; E.U = (bf16_t*)(p.ws + W_U); E.ZA = (bf16_t*)(p.ws + W_ZA); E.Q = (bf16_t*)(p.ws + W_Q); E.K = (bf16_t*)(p.ws + W_K); E.V = (bf16_t*)(p.ws + W_V); E.G = (bf16_t*)(p.ws + W_G); E.pool_scale = p.pool_scale;
    pg8::gemm_phase<EpiG1, SegOrder, false>(lds, g, S, E, nullptr);
}
constexpr int G1_SPLIT = 1536, N_SCAN_WG = 64;
DI void phase2(const Params& p, LAS unsigned char* lds, int rep) {
    if ((int)blockIdx.x < N_SCAN_WG) {
        for (int rr = 0; rr < ((PROBE_DUP & 64) ? 2 : 1); ++rr)
        for (int u = blockIdx.x; u < 64; u += N_SCAN_WG) { const int eh = (u >> 3) & 1, bh = (u & 7) + 8 * (u >> 4); scan_unit(p, bh >> 2, bh & 3, eh, lds); }
    } else {
        gemm1_run(p, lds, (int)gridDim.x - N_SCAN_WG, (int)blockIdx.x - N_SCAN_WG, G1_SPLIT, 1932);
        __syncthreads();
        for (int i = (int)blockIdx.x - N_SCAN_WG; i < NU0_WOUT; i += (int)gridDim.x - N_SCAN_WG) { const int pn = i >> 5, kb = i & 31;
            p0_transpose(p.w_out, 1024, 256 * pn, 256 * pn + 128, false, 1.f, (bf16_t*)(p.ws + W_WOUT) + (size_t)pn * 256 * 2048, 2048, 64 * kb, lds); }
    }
    __syncthreads();
    {
        unsigned* pctr = (unsigned*)(p.ws + W_CTR) + 8 + rep;
        for (;;) {
            __syncthreads();
            if (threadIdx.x == 0) *(LAS int*)(lds + L_CTL) = (int)atomicAdd(pctr, 1u);
            __syncthreads();
            const int pt = *(const LAS int*)(lds + L_CTL);
            if (pt >= 1096) break;
            pool_unit(p, pt >> 2, pt & 3, lds);
        }
        __syncthreads();
    }
    const int wv = __builtin_amdgcn_readfirstlane((int)(threadIdx.x >> 6));
    for (int qq = 0; qq < ((PROBE_DUP & 128) ? 2 : 1); ++qq) {
    unsigned* ctr = (unsigned*)(p.ws + W_CTR) + rep + 2 * qq;
    for (;;) {
        int item = 0;
        if ((threadIdx.x & 63) == 0) item = (int)atomicAdd(ctr, 1u);
        item = __builtin_amdgcn_readfirstlane(item);
        if (item >= N_ITEMS2) break;
        sample_wave_unit(p, item, lds + wv * SWR);
    }
    }
}

DI void ln_finish(const Params& p, int r, int lane, const u32x4 h0, const u32x4 h1, const u32x4 g0, const u32x4 g1) {
    bf16_t* Y = (bf16_t*)(p.ws + W_Y);
    const int ch = 16 * lane;
    float v[16] = {bf_lo(h0.x), bf_hi(h0.x), bf_lo(h0.y), bf_hi(h0.y), bf_lo(h0.z), bf_hi(h0.z), bf_lo(h0.w), bf_hi(h0.w),
                   bf_lo(h1.x), bf_hi(h1.x), bf_lo(h1.y), bf_hi(h1.y), bf_lo(h1.z), bf_hi(h1.z), bf_lo(h1.w), bf_hi(h1.w)};
    float s = 0.f;
#pragma unroll
    for (int i = 0; i < 16; ++i) s += v[i];
    s += __shfl_xor(s, 1); s += __shfl_xor(s, 2); s += __shfl_xor(s, 4); s += __shfl_xor(s, 8);
    const float mu = s * (1.f / 256.f);
    float q = 0.f;
#pragma unroll
    for (int i = 0; i < 16; ++i) { v[i] -= mu; q += v[i] * v[i]; }
    q += __shfl_xor(q, 1); q += __shfl_xor(q, 2); q += __shfl_xor(q, 4); q += __shfl_xor(q, 8);
    const float rstd = rsqrtf(q * (1.f / 256.f) + 1e-6f);
    const float gg[16] = {bf_lo(g0.x), bf_hi(g0.x), bf_lo(g0.y), bf_hi(g0.y), bf_lo(g0.z), bf_hi(g0.z), bf_lo(g0.w), bf_hi(g0.w),
                          bf_lo(g1.x), bf_hi(g1.x), bf_lo(g1.y), bf_hi(g1.y), bf_lo(g1.z), bf_hi(g1.z), bf_lo(g1.w), bf_hi(g1.w)};
    float o[16];
#pragma unroll
    for (int i = 0; i < 4; ++i) { const float4 w4 = *(const float4*)(p.mhln_w + ch + 4 * i);
        o[4 * i] = v[4 * i] * rstd * w4.x * gg[4 * i]; o[4 * i + 1] = v[4 * i + 1] * rstd * w4.y * gg[4 * i + 1];
        o[4 * i + 2] = v[4 * i + 2] * rstd * w4.z * gg[4 * i + 2]; o[4 * i + 3] = v[4 * i + 3] * rstd * w4.w * gg[4 * i + 3]; }
    u32x4 a, c;
    a.x = pk_bf16(o[0], o[1]); a.y = pk_bf16(o[2], o[3]); a.z = pk_bf16(o[4], o[5]); a.w = pk_bf16(o[6], o[7]);
    c.x = pk_bf16(o[8], o[9]); c.y = pk_bf16(o[10], o[11]); c.z = pk_bf16(o[12], o[13]); c.w = pk_bf16(o[14], o[15]);
    *(u32x4*)(Y + (size_t)r * 2048 + 1024 + ch) = a; *(u32x4*)(Y + (size_t)r * 2048 + 1024 + ch + 8) = c;
}
DI void phase3(const Params& p, LAS unsigned char* lds) {
    (void)lds;
    const int tid = opaque_tid(), lane = tid & 63, wid = __builtin_amdgcn_readfirstlane(tid >> 6);
    const bf16_t* HT = (const bf16_t*)(p.ws + W_HT); const bf16_t* G = (const bf16_t*)(p.ws + W_G); const bf16_t* U = (const bf16_t*)(p.ws + W_U);
    const int stride = gridDim.x * 8, ch = 16 * lane;
    for (int r = blockIdx.x * 8 + wid; r < T; r += 2 * stride) {
        const int r2 = r + stride < T ? r + stride : r;
        const u32x4 h0 = *(const u32x4*)(HT + (size_t)r * 1024 + ch), h1 = *(const u32x4*)(HT + (size_t)r * 1024 + ch + 8);
        const u32x4 g0 = *(const u32x4*)(G + (size_t)r * 1024 + ch), g1 = *(const u32x4*)(G + (size_t)r * 1024 + ch + 8);
        const u32x4 h2 = *(const u32x4*)(HT + (size_t)r2 * 1024 + ch), h3 = *(const u32x4*)(HT + (size_t)r2 * 1024 + ch + 8);
        const u32x4 g2 = *(const u32x4*)(G + (size_t)r2 * 1024 + ch), g3 = *(const u32x4*)(G + (size_t)r2 * 1024 + ch + 8);
        ln_finish(p, r, lane, h0, h1, g0, g1);
        if (r2 != r) ln_finish(p, r2, lane, h2, h3, g2, g3);
    }
    for (int i = blockIdx.x * 512 + tid; i < 16384; i += gridDim.x * 512) ((float*)(p.ws + W_RSS))[i] = 0.f;
    const int gtid = (int)blockIdx.x * 512 + tid, gstr = (int)gridDim.x * 512;
    for (int i = gtid; i < 122880 / 4; i += gstr) { const int c = (i & 255) * 4, ri = i >> 8, b = ri / 15, k = ri - b * 15;
        const u32x2 v = *(const u32x2*)(U + (size_t)(b * TPR + 2049 + k) * 1024 + c);
        f32x4 o; o[0] = bf_lo(v.x); o[1] = bf_hi(v.x); o[2] = bf_lo(v.y); o[3] = bf_hi(v.y);
        __builtin_nontemporal_store(o, (f32x4*)(p.out + O_PP + (size_t)i * 4)); }
    for (int i = gtid; i < 1966080 / 4; i += gstr) { const int c = (i & 255) * 4, ri = i >> 8, b = ri / 15, k = ri - b * 15;
        f32x4 o;
        if (k < 7) o = __builtin_nontemporal_load((const f32x4*)(p.state_pool + ((size_t)b * 15 + 8 + k) * 1024 + c));
        else { const u32x2 v = *(const u32x2*)(U + (size_t)(ROWS_P + b * 8 + k - 7) * 1024 + c); o[0] = bf_lo(v.x); o[1] = bf_hi(v.x); o[2] = bf_lo(v.y); o[3] = bf_hi(v.y); }
        __builtin_nontemporal_store(o, (f32x4*)(p.out + O_PS + (size_t)i * 4)); }
}

DI void p5_load(const Params& p, int o, int lane, float4 (&v)[4]) {
    const int R = o < 16384 ? (o >> 11) * TPR + (o & 2047) + NMETA : ROWS_P + (o - 16384);
    if (R >= 16384) {
        const float* xr = o < 16384 ? p.x_prompt + (size_t)o * 1024 : p.x_sample + (size_t)(o - 16384) * 1024;
        const float* pp = (const float*)(p.ws + W_Q) + (size_t)(R - 16384) * 1024;
#pragma unroll
        for (int j = 0; j < 4; ++j) { v[j] = *(const float4*)(xr + 4 * lane + 256 * j);
#pragma unroll
            for (int ks = 0; ks < 8; ++ks) { const float4 q = *(const float4*)(pp + (size_t)ks * 1280 * 1024 + 4 * lane + 256 * j); v[j].x += q.x; v[j].y += q.y; v[j].z += q.z; v[j].w += q.w; } }
    } else {
        const float* row = p.out + (size_t)o * 1024;
#pragma unroll
        for (int j = 0; j < 4; ++j) v[j] = *(const float4*)(row + 4 * lane + 256 * j);
    }
}
DI void p5_finish(const Params& p, int o, int lane, float4 (&v)[4]) {
    float ss = 0.f;
#pragma unroll
    for (int j = 0; j < 4; ++j) ss += v[j].x * v[j].x + v[j].y * v[j].y + v[j].z * v[j].z + v[j].w * v[j].w;
    ss = wave_sum(ss);
    const float rstd = rsqrtf(ss * (1.f / 1024.f) + 1e-6f);
    float* row = p.out + (size_t)o * 1024;
#pragma unroll
    for (int j = 0; j < 4; ++j) { const float4 w = *(const float4*)(p.normf_w + 4 * lane + 256 * j);
        f32x4 o_; o_[0] = v[j].x * rstd * w.x; o_[1] = v[j].y * rstd * w.y; o_[2] = v[j].z * rstd * w.z; o_[3] = v[j].w * rstd * w.w; __builtin_nontemporal_store(o_, (f32x4*)(row + 4 * lane + 256 * j)); }
}
DI void phase5(const Params& p) {
    const int tid = opaque_tid(), lane = tid & 63, wid = __builtin_amdgcn_readfirstlane(tid >> 6);
    const int N = 16384 + 1024, stride = gridDim.x * 8;
    for (int o = 16256 + blockIdx.x * 8 + wid; o < N; o += 2 * stride) {
        const int o2 = o + stride; const bool has2 = o2 < N;
        float4 va[4], vb[4];
        p5_load(p, o, lane, va);
        if (has2) p5_load(p, o2, lane, vb);
        p5_finish(p, o, lane, va);
        if (has2) p5_finish(p, o2, lane, vb);
    }
}

DI void run_phase(const Params& p, int ph, LAS unsigned char* lds, int rep = 0) {
    if (ph == 0) phase0(p, lds);
    else if (ph == 1) { gemm1_run(p, lds, (int)gridDim.x, (int)blockIdx.x, 0, G1_SPLIT);
    } else if (ph == 2) phase2(p, lds, rep);
    else if (ph == 3) phase3(p, lds);
    else if (ph == 4) {
        pg8::Gemm g; g.A = (const bf16_t*)(p.ws + W_Y); g.Bt = (const bf16_t*)(p.ws + W_WOUT); g.M = TP; g.N = 1024; g.K = 2048;
        G2Order S; S.G = (int)gridDim.x; S.c = (int)blockIdx.x;
        EpiG2 E; E.x_prompt = p.x_prompt; E.xs_delta = (long)(p.x_sample - p.x_prompt); E.out = p.out; E.part = (float*)(p.ws + W_Q); E.rss = (float*)(p.ws + W_RSS); E.pcnt = (unsigned*)(p.ws + W_BAR) + 3456; E.normf_w = p.normf_w;
        pg8::gemm_phase<EpiG2, G2Order, false>(lds, g, S, E, nullptr);
    } else phase5(p);
}

template <bool COOP, int PH> __global__ __launch_bounds__(512, 2) void hymba_mega(Params p) {
    extern __shared__ __attribute__((aligned(16))) unsigned char smem[];
    LAS unsigned char* lds = (LAS unsigned char*)smem;
    if constexpr (COOP) {
        cg::grid_group grid = cg::this_grid();
        if (p.phase_hi == 777) grid.sync();
        if (threadIdx.x == 0) { *(LAS unsigned*)(lds + L_XB) = 0u; *(LAS unsigned*)(lds + L_XB + 4) = 0u; }
        __syncthreads();
        const XcdBarrier xb = xcd_barrier_post((unsigned*)(p.ws + W_BAR), (volatile LAS unsigned*)(lds + L_XB));
#define GSYNC() xcd_barrier(xb)
#define RUNPH(k) do { run_phase(p, k, lds); if (PROBE_DUP & (1 << k)) { GSYNC(); run_phase(p, k, lds, 1); } } while (0)
        RUNPH(0); GSYNC(); RUNPH(1); GSYNC(); RUNPH(2); GSYNC(); RUNPH(3); GSYNC(); RUNPH(4); GSYNC();
        if (PROBE_DUP & 32) { run_phase(p, 4, lds, 1); GSYNC(); }
        if (PROBE_DUP & 256) { GSYNC(); GSYNC(); GSYNC(); GSYNC(); }
        run_phase(p, 5, lds);
    } else {
        run_phase(p, PH, lds);
    }
}

extern "C" void kernel_launch(void* const* d_in, const int* in_sizes, int n_in, void* d_out, int out_size, void* d_ws, size_t ws_size, hipStream_t stream) {
    (void)in_sizes; (void)n_in; (void)out_size; (void)ws_size;
    Params p{};
    p.x_prompt = (const float*)d_in[0]; p.x_sample = (const float*)d_in[1]; p.state_pool = (const float*)d_in[2]; p.state_C = (const float*)d_in[3];
    p.state_n = (const float*)d_in[4]; p.state_m = (const float*)d_in[5]; p.meta = (const float*)d_in[6]; p.norm1_w = (const float*)d_in[7];
    p.w_in = (const float*)d_in[8]; p.b_if = (const float*)d_in[9]; p.w_pool = (const float*)d_in[10]; p.pool_scale = (const float*)d_in[11];
    p.mhln_w = (const float*)d_in[12]; p.w_out = (const float*)d_in[13]; p.normf_w = (const float*)d_in[14];
    p.out = (float*)d_out; p.ws = (unsigned char*)d_ws;
    static int grid_blocks = 0;
    if (!grid_blocks) {
        int dev = 0, cus = 0, per_cu = 0;
        (void)hipGetDevice(&dev);
        (void)hipDeviceGetAttribute(&cus, hipDeviceAttributeMultiprocessorCount, dev);
#if MK_MULTI
        (void)hipFuncSetAttribute((const void*)hymba_mega<false, 0>, hipFuncAttributeMaxDynamicSharedMemorySize, LDS_BYTES);
        (void)hipFuncSetAttribute((const void*)hymba_mega<false, 1>, hipFuncAttributeMaxDynamicSharedMemorySize, LDS_BYTES);
        (void)hipFuncSetAttribute((const void*)hymba_mega<false, 2>, hipFuncAttributeMaxDynamicSharedMemorySize, LDS_BYTES);
        (void)hipFuncSetAttribute((const void*)hymba_mega<false, 3>, hipFuncAttributeMaxDynamicSharedMemorySize, LDS_BYTES);
        (void)hipFuncSetAttribute((const void*)hymba_mega<false, 4>, hipFuncAttributeMaxDynamicSharedMemorySize, LDS_BYTES);
        (void)hipFuncSetAttribute((const void*)hymba_mega<false, 5>, hipFuncAttributeMaxDynamicSharedMemorySize, LDS_BYTES);
        per_cu = 1;
#else
        (void)hipFuncSetAttribute((const void*)hymba_mega<true, 0>, hipFuncAttributeMaxDynamicSharedMemorySize, LDS_BYTES);
        (void)hipOccupancyMaxActiveBlocksPerMultiprocessor(&per_cu, hymba_mega<true, 0>, 512, LDS_BYTES);
#endif
        if (per_cu < 1) per_cu = 1;
        grid_blocks = cus * per_cu;
    }
#if MK_MULTI
    hipLaunchKernelGGL((hymba_mega<false, 0>), dim3(grid_blocks), dim3(512), LDS_BYTES, stream, p);
    hipLaunchKernelGGL((hymba_mega<false, 1>), dim3(grid_blocks), dim3(512), LDS_BYTES, stream, p);
    hipLaunchKernelGGL((hymba_mega<false, 2>), dim3(grid_blocks), dim3(512), LDS_BYTES, stream, p);
    hipLaunchKernelGGL((hymba_mega<false, 3>), dim3(grid_blocks), dim3(512), LDS_BYTES, stream, p);
    hipLaunchKernelGGL((hymba_mega<false, 4>), dim3(grid_blocks), dim3(512), LDS_BYTES, stream, p);
    hipLaunchKernelGGL((hymba_mega<false, 5>), dim3(grid_blocks), dim3(512), LDS_BYTES, stream, p);
#else
    p.phase_lo = 0; p.phase_hi = 5;
    (void)hipMemsetAsync((unsigned char*)d_ws + W_CTR, 0, 256 + 16384, stream);
    void* args[] = {&p};
    hipError_t e = hipLaunchCooperativeKernel((const void*)hymba_mega<true, 0>, dim3(grid_blocks), dim3(512), args, LDS_BYTES, stream);
    if (e != hipSuccess) fprintf(stderr, "cooperative launch failed: %s (grid %d)\n", hipGetErrorString(e), grid_blocks);
#endif
}
```
